# Optimizing an MI355X kernel written in HIP

```python
import math
import jax, jax.numpy as jnp
from jax import lax
import numpy as np

D_MODEL = 4096
BATCH = 2
SEQ = 4096
DEPTH = 1

N_META = 16
ATTN_WIDTH = D_MODEL // 2
LRU_WIDTH = D_MODEL - ATTN_WIDTH
DIFF_QK_DIM = 128
DIFF_V_DIM = 2 * DIFF_QK_DIM
DIFF_HEADS = ATTN_WIDTH // DIFF_V_DIM
LRU_HEADS = 16
LRU_BLOCK = LRU_WIDTH // LRU_HEADS
CONV_WIDTH = 4
LRU_C = 8.0
D_FF = ((-(-8 * D_MODEL // 3)) + 255) // 256 * 256
IN_WIDTH = 3 * ATTN_WIDTH + 2 * LRU_WIDTH
ROPE_THETA = 10000.0
BLOCK_Q = 128
RMS_EPS = 1e-6

kernel_name = 'hymba_diffattn_rglru_sandwich'


def rms_norm(x, g):
    xf = x.astype(jnp.float32)
    y = xf * lax.rsqrt(jnp.mean(xf * xf, axis=-1, keepdims=True) + RMS_EPS)
    return (y * g.astype(jnp.float32)).astype(x.dtype)


def rotary_tables(T):
    inv_freq = 1.0 / (ROPE_THETA ** (jnp.arange(0, DIFF_QK_DIM, 2, dtype=jnp.float32) / DIFF_QK_DIM))
    ang = jnp.arange(T, dtype=jnp.float32)[:, None] * inv_freq[None, :]
    return jnp.cos(ang), jnp.sin(ang)


def apply_rope(x, cos, sin):
    half = x.shape[-1] // 2
    xf = x.astype(jnp.float32)
    x1, x2 = xf[..., :half], xf[..., half:]
    c = cos[None, :, None, None, :]
    s = sin[None, :, None, None, :]
    return jnp.concatenate([x1 * c - x2 * s, x2 * c + x1 * s], axis=-1).astype(x.dtype)


def diff_attention(q, k, v, lam, subln_g, lambda_init):
    B, T = q.shape[0], q.shape[1]
    scale = DIFF_QK_DIM ** -0.5
    outs = []
    for start in range(0, T, BLOCK_Q):
        end = start + BLOCK_Q
        qb = q[:, start:end]
        kb = k[:, :end]
        vb = v[:, :end]
        s = jnp.einsum('bqhcd,bkhcd->bhcqk', qb, kb).astype(jnp.float32) * scale
        qpos = jnp.arange(start, end)
        kpos = jnp.arange(end)
        mask = kpos[None, :] <= qpos[:, None]
        s = jnp.where(mask, s, -jnp.inf)
        p = jax.nn.softmax(s, axis=-1)
        w = p[:, :, 0] - lam * p[:, :, 1]
        outs.append(jnp.einsum('bhqk,bkhd->bqhd', w.astype(v.dtype), vb))
    o = jnp.concatenate(outs, axis=1)
    o = rms_norm(o, subln_g) * (1.0 - lambda_init)
    return o.reshape(B, T, DIFF_HEADS * DIFF_V_DIM)


def rg_lru_branch(xr, gate, conv_w, conv_b, w_r, b_r, w_i, b_i, lru_lambda):
    B, T, C = xr.shape
    xc = lax.conv_general_dilated(
        xr, conv_w[:, None, :].astype(xr.dtype), window_strides=(1,),
        padding=[(CONV_WIDTH - 1, 0)], dimension_numbers=('NWC', 'WIO', 'NWC'),
        feature_group_count=C) + conv_b
    xh = xc.reshape(B, T, LRU_HEADS, LRU_BLOCK)
    r = jax.nn.sigmoid(jnp.einsum('bthi,hij->bthj', xh, w_r).reshape(B, T, C) + b_r)
    i = jax.nn.sigmoid(jnp.einsum('bthi,hij->bthj', xh, w_i).reshape(B, T, C) + b_i)
    log_a = -LRU_C * r.astype(jnp.float32) * jax.nn.softplus(-lru_lambda.astype(jnp.float32))
    a = jnp.exp(log_a)
    mult = jnp.sqrt(-jnp.expm1(2.0 * log_a))
    bterm = mult * (i * xc).astype(jnp.float32)

    def combine(left, right):
        a_l, b_l = left
        a_r, b_r2 = right
        return a_l * a_r, a_r * b_l + b_r2

    _, h = lax.associative_scan(combine, (a, bterm), axis=1)
    return h.astype(xr.dtype) * jax.nn.gelu(gate)


def setup_inputs(seed: int = 0) -> dict:
    key = jax.random.key(seed)
    ks = jax.random.split(key, 24)
    f32 = jnp.float32
    nrm = lambda k, shp, sc: jax.random.normal(k, shp, f32) * sc
    u = jax.random.uniform(ks[14], (DEPTH, LRU_WIDTH), f32, 0.9, 0.999)
    a0 = u ** (1.0 / LRU_C)
    lru_lambda = jnp.log(a0) - jnp.log1p(-a0)
    return {
        'x': nrm(ks[0], (BATCH, SEQ, D_MODEL), 1.0),
        'meta_tokens': nrm(ks[1], (N_META, D_MODEL), 1.0),
        'mix_pre_g': 1.0 + nrm(ks[2], (DEPTH, D_MODEL), 0.02),
        'w_in': nrm(ks[3], (DEPTH, D_MODEL, IN_WIDTH), D_MODEL ** -0.5),
        'lambda_q1': nrm(ks[4], (DEPTH, DIFF_QK_DIM), 0.1),
        'lambda_k1': nrm(ks[5], (DEPTH, DIFF_QK_DIM), 0.1),
        'lambda_q2': nrm(ks[6], (DEPTH, DIFF_QK_DIM), 0.1),
        'lambda_k2': nrm(ks[7], (DEPTH, DIFF_QK_DIM), 0.1),
        'subln_g': 1.0 + nrm(ks[8], (DEPTH, DIFF_V_DIM), 0.02),
        'conv_w': nrm(ks[9], (DEPTH, CONV_WIDTH, LRU_WIDTH), CONV_WIDTH ** -0.5),
        'conv_b': nrm(ks[10], (DEPTH, LRU_WIDTH), 0.02),
        'w_r': nrm(ks[11], (DEPTH, LRU_HEADS, LRU_BLOCK, LRU_BLOCK), LRU_BLOCK ** -0.5),
        'b_r': nrm(ks[12], (DEPTH, LRU_WIDTH), 0.02),
        'w_i': nrm(ks[13], (DEPTH, LRU_HEADS, LRU_BLOCK, LRU_BLOCK), LRU_BLOCK ** -0.5),
        'b_i': nrm(ks[15], (DEPTH, LRU_WIDTH), 0.02),
        'lru_lambda': lru_lambda,
        'w_out': nrm(ks[16], (DEPTH, ATTN_WIDTH + LRU_WIDTH, D_MODEL), (ATTN_WIDTH + LRU_WIDTH) ** -0.5),
        'mix_post_g': 1.0 + nrm(ks[17], (DEPTH, D_MODEL), 0.02),
        'ffn_pre_g': 1.0 + nrm(ks[18], (DEPTH, D_MODEL), 0.02),
        'w_gate': nrm(ks[19], (DEPTH, D_MODEL, D_FF), D_MODEL ** -0.5),
        'w_up': nrm(ks[20], (DEPTH, D_MODEL, D_FF), D_MODEL ** -0.5),
        'w_down': nrm(ks[21], (DEPTH, D_FF, D_MODEL), D_FF ** -0.5),
        'ffn_post_g': 1.0 + nrm(ks[22], (DEPTH, D_MODEL), 0.02),
    }


def reference(x, meta_tokens, mix_pre_g, w_in, lambda_q1, lambda_k1, lambda_q2, lambda_k2,
              subln_g, conv_w, conv_b, w_r, b_r, w_i, b_i, lru_lambda, w_out, mix_post_g,
              ffn_pre_g, w_gate, w_up, w_down, ffn_post_g):
    B, S, D = x.shape
    T = N_META + S
    T_pad = -(-T // BLOCK_Q) * BLOCK_Q
    meta = jnp.broadcast_to(meta_tokens[None].astype(x.dtype), (B, N_META, D))
    h = jnp.concatenate([meta, x, jnp.zeros((B, T_pad - T, D), x.dtype)], axis=1)
    cos, sin = rotary_tables(T_pad)
    splits = [ATTN_WIDTH, 2 * ATTN_WIDTH, 3 * ATTN_WIDTH, 3 * ATTN_WIDTH + LRU_WIDTH]
    for l in range(DEPTH):
        lambda_init = 0.8 - 0.6 * math.exp(-0.3 * l)
        u = rms_norm(h, mix_pre_g[l])
        proj = u @ w_in[l]
        q, k, v, xr, gate = jnp.split(proj, splits, axis=-1)
        q = apply_rope(q.reshape(B, T_pad, DIFF_HEADS, 2, DIFF_QK_DIM), cos, sin)
        k = apply_rope(k.reshape(B, T_pad, DIFF_HEADS, 2, DIFF_QK_DIM), cos, sin)
        v = v.reshape(B, T_pad, DIFF_HEADS, DIFF_V_DIM)
        lam = (jnp.exp(jnp.sum(lambda_q1[l].astype(jnp.float32) * lambda_k1[l].astype(jnp.float32)))
               - jnp.exp(jnp.sum(lambda_q2[l].astype(jnp.float32) * lambda_k2[l].astype(jnp.float32)))
               + lambda_init)
        attn = diff_attention(q, k, v, lam, subln_g[l], lambda_init)
        rec = rg_lru_branch(xr, gate, conv_w[l], conv_b[l], w_r[l], b_r[l],
                            w_i[l], b_i[l], lru_lambda[l])
        mixed = jnp.concatenate([attn, rec], axis=-1) @ w_out[l]
        h = h + rms_norm(mixed, mix_post_g[l])
        u = rms_norm(h, ffn_pre_g[l])
        f = (jax.nn.silu(u @ w_gate[l]) * (u @ w_up[l])) @ w_down[l]
        h = h + rms_norm(f, ffn_post_g[l])
    return h[:, N_META:N_META + S]
```

```cpp
#include <hip/hip_runtime.h>
#include <hip/hip_bf16.h>
#include <hip/hip_cooperative_groups.h>
#include <cstdio>
#include <cstdint>
namespace cg = cooperative_groups;
namespace pg8 {
#define PG8_LAS __attribute__((address_space(3)))
typedef unsigned short bf16_t;
typedef short bf16x8 __attribute__((ext_vector_type(8)));
typedef float f32x4 __attribute__((ext_vector_type(4)));
typedef unsigned u32x4 __attribute__((ext_vector_type(4)));
constexpr int BM = 256, BK = 64, HALF = 128, HTB = HALF * BK * 2  , STAGE_BYTES = 8 * HTB, NXCD = 8, WGM = 8;

__host__ __device__ __forceinline__ int lds_byte(int r, int c) { const int st = (r >> 4) * 2 + (c >> 5), rr = r & 15, cc = c & 31, ob = rr * 64 + cc * 2; return st * 1024 + (ob ^ (((ob >> 9) & 1) << 5)); }
__host__ __device__ __forceinline__ void stage_rc(int b, int& R, int& C) { const int st = b / 1024, sb = b % 1024, swz = sb ^ (((sb >> 9) & 1) << 5); R = (st >> 1) * 16 + swz / 64; C = (st & 1) * 32 + (swz % 64) / 2; }
__host__ __device__ __forceinline__ int perm32(int rho) { const int n = rho >> 4, i = rho & 15; return 8 * (i >> 2) + 4 * n + (i & 3); }

struct Unit { int pm, pn; };
struct Gemm { const bf16_t* A; const bf16_t* Bt; int M, N, K; };

struct StaticOrder {
    int nM, nN, nwg, G, c;
    __host__ __device__ void init(int M, int N, int G_, int c_) { nM = M / BM; nN = N / BM; nwg = nM * nN; G = G_; c = c_; }
    __host__ __device__ bool next(int i, Unit& u) const {
        const long L = (long)i * G + c; if (L >= nwg) return false;
        int wgid = (int)L; { const int q = nwg / NXCD, r = nwg % NXCD, xcd = wgid % NXCD, off = wgid / NXCD; wgid = (xcd < r ? xcd * (q + 1) : r * (q + 1) + (xcd - r) * q) + off; }
        const int nig = WGM * nN, gid = wgid / nig, fm = gid * WGM, gsz = (nM - fm) < WGM ? (nM - fm) : WGM;
        u.pm = fm + ((wgid % nig) % gsz); u.pn = (wgid % nig) / gsz; return true;
    }
    __device__ __forceinline__ void a_ready(const Unit&) const {}
    __device__ __forceinline__ void done(const Unit&) const {}
};

__device__ __forceinline__ unsigned cvt_pk_bf16(float lo, float hi) { unsigned r; asm volatile("v_cvt_pk_bf16_f32 %0, %1, %2" : "=v"(r) : "v"(lo), "v"(hi)); return r; }
__device__ __forceinline__ u32x4 pack8f(const f32x4 a, const f32x4 b) { u32x4 w; w.x = cvt_pk_bf16(a[0], a[1]); w.y = cvt_pk_bf16(a[2], a[3]); w.z = cvt_pk_bf16(b[0], b[1]); w.w = cvt_pk_bf16(b[2], b[3]); return w; }
constexpr int TPAD = 4224, NMETA_ = 16, QKV_ROWS = 2 * TPAD;
struct EpiIn {
    static constexpr bool PERM = true, AFTER_DRAIN = false;
    bf16_t* base; const float* cosT; const float* sinT; const float* rs1;
    __device__ __forceinline__ void operator()(const f32x4 (&acc)[2][2][4][2], const Unit& u, int wr, int wc, int fr, int fq) const {
        const int sect = u.pn >> 3, hd = u.pn & 7;
        bf16_t* buf = base + (size_t)sect * ((size_t)QKV_ROWS * 2048);
        const int j0 = wc * 32 + 8 * fq;
#pragma unroll
        for (int ai = 0; ai < 2; ++ai)
#pragma unroll
            for (int m = 0; m < 4; ++m) {
                const int grow = u.pm * BM + ai * HALF + wr * 64 + m * 16 + fr;
                const int pos = NMETA_ + (grow & 4095), srow = (grow >> 12) * TPAD + pos;
                const float rr = rs1[grow];
                const f32x4 a00 = acc[ai][0][m][0] * rr, a01 = acc[ai][0][m][1] * rr, a10 = acc[ai][1][m][0] * rr, a11 = acc[ai][1][m][1] * rr;
                if (sect < 2) {
                    const int comp = j0 >> 6, i0 = j0 & 63;
                    const f32x4 c0 = *(const f32x4*)(cosT + pos * 64 + i0), c1 = *(const f32x4*)(cosT + pos * 64 + i0 + 4);
                    const f32x4 s0 = *(const f32x4*)(sinT + pos * 64 + i0), s1 = *(const f32x4*)(sinT + pos * 64 + i0 + 4);
                    const f32x4 x1a = a00, x1b = a01, x2a = a10, x2b = a11;
                    const f32x4 o1a = x1a * c0 - x2a * s0, o1b = x1b * c1 - x2b * s1, o2a = x2a * c0 + x1a * s0, o2b = x2b * c1 + x1b * s1;
                    const u32x4 w1 = pack8f(o1a, o1b), w2 = pack8f(o2a, o2b);
                    bf16_t* p = buf + (size_t)srow * 2048 + hd * 256 + comp * 128 + i0;
                    *(u32x4*)p = w1; *(u32x4*)(p + 64) = w2;
                } else {
#pragma unroll
                    for (int bj = 0; bj < 2; ++bj) { const u32x4 w = bj ? pack8f(a10, a11) : pack8f(a00, a01);
                        bf16_t* p = buf + (size_t)srow * 2048 + hd * 256 + bj * HALF + j0;
                        *(u32x4*)p = w; }
                }
            }
    }
};
struct EpiBfSsq {
    static constexpr bool PERM = true, AFTER_DRAIN = false;
    bf16_t* O; float* ssq; int ldc;
    __device__ __forceinline__ void operator()(const f32x4 (&acc)[2][2][4][2], const Unit& u, int wr, int wc, int fr, int fq) const {
        const int col0 = u.pn * BM + wc * 32 + 8 * fq;
#pragma unroll
        for (int ai = 0; ai < 2; ++ai)
#pragma unroll
            for (int m = 0; m < 4; ++m) {
                const int row = u.pm * BM + ai * HALF + wr * 64 + m * 16 + fr; float s = 0.f;
                bf16_t* rowp = O + (size_t)row * ldc + col0;
#pragma unroll
                for (int bj = 0; bj < 2; ++bj) { const f32x4 v0 = acc[ai][bj][m][0], v1 = acc[ai][bj][m][1];
                    *(u32x4*)(rowp + bj * HALF) = pack8f(v0, v1);
                    s += (v0[0] * v0[0] + v0[1] * v0[1]) + (v0[2] * v0[2] + v0[3] * v0[3]) + (v1[0] * v1[0] + v1[1] * v1[1]) + (v1[2] * v1[2] + v1[3] * v1[3]); }
                s += __shfl_xor(s, 16); s += __shfl_xor(s, 32);
                if (fq == 0) ssq[(size_t)row * 64 + u.pn * 4 + wc] = s;
            }
    }
};
struct EpiGU {
    static constexpr bool PERM = true, AFTER_DRAIN = false;
    bf16_t* O; int ldc; const float* rs;
    __device__ __forceinline__ void operator()(const f32x4 (&acc)[2][2][4][2], const Unit& u, int wr, int wc, int fr, int fq) const {
        const int col0 = u.pn * HALF + wc * 32 + 8 * fq;
#pragma unroll
        for (int ai = 0; ai < 2; ++ai)
#pragma unroll
            for (int m = 0; m < 4; ++m) {
                const int row = u.pm * BM + ai * HALF + wr * 64 + m * 16 + fr; const float rr = rs[row];
                f32x4 r0, r1;
#pragma unroll
                for (int e = 0; e < 4; ++e) {
                    const float g0 = acc[ai][0][m][0][e] * rr, g1 = acc[ai][0][m][1][e] * rr;
                    r0[e] = g0 * __builtin_amdgcn_rcpf(1.f + __builtin_amdgcn_exp2f(-1.4426950408889634f * g0)) * (acc[ai][1][m][0][e] * rr);
                    r1[e] = g1 * __builtin_amdgcn_rcpf(1.f + __builtin_amdgcn_exp2f(-1.4426950408889634f * g1)) * (acc[ai][1][m][1][e] * rr);
                }
                *(u32x4*)(O + (size_t)row * ldc + col0) = pack8f(r0, r1);
            }
    }
};

template <class Epi, class Sched, bool ALIGN_EPI = false, bool SP2 = false>
__device__ __forceinline__ void gemm_phase(PG8_LAS unsigned char* lds, const Gemm g, const Sched& S, const Epi& E) {
    const int tid = threadIdx.x, wid = __builtin_amdgcn_readfirstlane(tid >> 6), lane = tid & 63, wr = wid >> 2, wc = wid & 3, fr = lane & 15, fq = lane >> 4;
    const int K = g.K, nt = K / BK;
    unsigned voffA[2], voffB[2];
#pragma unroll
    for (int i = 0; i < 2; ++i) { int R, C; stage_rc(tid * 16 + i * 8192, R, C); const int Rb = Epi::PERM ? ((R & ~31) + perm32(R & 31)) : R;
        voffA[i] = (unsigned)(R * K + C) * 2u; voffB[i] = (unsigned)(Rb * K + C) * 2u; }
    const size_t kstep = (size_t)(BK * 2);
    const size_t hstep = (size_t)HALF * K * 2;
    const size_t tstep = 2 * hstep;
    const unsigned ldsw = (unsigned)wid * 1024u;
    const int aoff = lds_byte(wr * 64 + fr, fq * 8), boff = lds_byte(wc * 32 + fr, fq * 8);
#define PG8_SA(b, h) (((b) * 2 + (h)) * HTB)
#define PG8_SB(b, h) ((4 + (b) * 2 + (h)) * HTB)
#define PG8_STAGE(bufoff, gbase, voff) do { _Pragma("unroll") for (int _i = 0; _i < 2; ++_i) \
        __builtin_amdgcn_global_load_lds((const unsigned*)((const char*)(gbase) + (voff)[_i]), (PG8_LAS unsigned*)(lds + (bufoff) + ldsw + _i * 8192), 16, 0, 0); } while (0)
#define PG8_LDA(dst, b, h) do { _Pragma("unroll") for (int m = 0; m < 4; ++m) _Pragma("unroll") for (int k = 0; k < 2; ++k) dst[m][k] = *(const PG8_LAS bf16x8*)(lds + PG8_SA(b, h) + aoff + m * 2048 + k * 1024); } while (0)
#define PG8_LDB(dst, b, h) do { _Pragma("unroll") for (int n = 0; n < 2; ++n) _Pragma("unroll") for (int k = 0; k < 2; ++k) dst[n][k] = *(const PG8_LAS bf16x8*)(lds + PG8_SB(b, h) + boff + n * 2048 + k * 1024); } while (0)
#define PG8_MMA(ai, bj, At, Bt) do { __builtin_amdgcn_s_setprio(1); _Pragma("unroll") for (int m = 0; m < 4; ++m) _Pragma("unroll") for (int n = 0; n < 2; ++n) _Pragma("unroll") for (int k = 0; k < 2; ++k) \
        acc[ai][bj][m][n] = __builtin_amdgcn_mfma_f32_16x16x32_bf16(Bt[n][k], At[m][k], acc[ai][bj][m][n], 0, 0, 0); __builtin_amdgcn_s_setprio(0); } while (0)
#define PG8_WAIT_V(n) asm volatile("s_waitcnt vmcnt(" #n ")" ::: "memory")
#define PG8_WAIT_L(n) asm volatile("s_waitcnt lgkmcnt(" #n ")" ::: "memory")
#define PG8_BAR __builtin_amdgcn_s_barrier()
#define PG8_SCHED __builtin_amdgcn_sched_barrier(0)
    Unit cur, nxt; int ui = 0;
    if (!S.next(0, cur)) return;
    f32x4 acc[2][2][4][2];
#pragma unroll
    for (int a = 0; a < 2; ++a)
#pragma unroll
        for (int b = 0; b < 2; ++b)
#pragma unroll
            for (int m = 0; m < 4; ++m)
#pragma unroll
                for (int n = 0; n < 2; ++n) acc[a][b][m][n] = (f32x4){0.f, 0.f, 0.f, 0.f};
    bf16x8 At[4][2], B0[2][2], B1[2][2];
    const char* cA = (const char*)g.A + (size_t)cur.pm * tstep; const char* cB = (const char*)g.Bt + (size_t)cur.pn * tstep;
    S.a_ready(cur);
    if constexpr (SP2) {
        PG8_STAGE(PG8_SB(0, 0), cB, voffB); PG8_STAGE(PG8_SB(0, 1), cB + hstep, voffB); PG8_STAGE(PG8_SA(0, 0), cA, voffA); PG8_STAGE(PG8_SA(0, 1), cA + hstep, voffA);
        if (wr == 1) PG8_BAR;
        PG8_WAIT_V(2); PG8_BAR;
        PG8_STAGE(PG8_SB(1, 0), cB + kstep, voffB); PG8_STAGE(PG8_SA(1, 0), cA + kstep, voffA); PG8_STAGE(PG8_SB(1, 1), cB + hstep + kstep, voffB);
        PG8_WAIT_V(6); PG8_BAR;
    } else {
        PG8_STAGE(PG8_SB(0, 0), cB, voffB); PG8_STAGE(PG8_SA(0, 0), cA, voffA); PG8_STAGE(PG8_SB(0, 1), cB + hstep, voffB); PG8_STAGE(PG8_SA(0, 1), cA + hstep, voffA);
        if (wr == 1) PG8_BAR;
        PG8_WAIT_V(4); PG8_BAR;
        PG8_STAGE(PG8_SB(1, 0), cB + kstep, voffB); PG8_STAGE(PG8_SA(1, 0), cA + kstep, voffA); PG8_STAGE(PG8_SB(1, 1), cB + hstep + kstep, voffB);
        PG8_WAIT_V(6); PG8_BAR;
    }
    for (;;) {
        const bool has_next = S.next(ui + 1, nxt);
        const char* nA = has_next ? (const char*)g.A + (size_t)nxt.pm * tstep : cA; const char* nB = has_next ? (const char*)g.Bt + (size_t)nxt.pn * tstep : cB;
        for (int t = 0; t < nt; t += 2) {
            const bool last = (t == nt - 2);
            const char* a1 = cA + (size_t)(t + 1) * kstep;
            const char* a2 = last ? nA : cA + (size_t)(t + 2) * kstep; const char* b2 = last ? nB : cB + (size_t)(t + 2) * kstep;
            const char* a3 = a2 + kstep; const char* b3 = b2 + kstep;
            if (last && has_next) S.a_ready(nxt);
            if constexpr (SP2) {
            PG8_LDB(B0, 0, 0); PG8_LDB(B1, 0, 1); PG8_SCHED; PG8_LDA(At, 0, 0); PG8_STAGE(PG8_SA(1, 1), a1 + hstep, voffA);
            PG8_WAIT_V(8); PG8_WAIT_L(0); PG8_BAR; PG8_MMA(0, 0, At, B0); PG8_MMA(0, 1, At, B1); PG8_BAR; PG8_SCHED;
            PG8_LDA(At, 0, 1); PG8_STAGE(PG8_SB(0, 0), b2, voffB); PG8_STAGE(PG8_SB(0, 1), b2 + hstep, voffB); PG8_STAGE(PG8_SA(0, 0), a2, voffA);
            PG8_WAIT_V(8); PG8_WAIT_L(0); PG8_BAR; PG8_MMA(1, 0, At, B0); PG8_MMA(1, 1, At, B1); PG8_BAR; PG8_SCHED;
            PG8_LDB(B0, 1, 0); PG8_LDB(B1, 1, 1); PG8_SCHED; PG8_LDA(At, 1, 0); PG8_STAGE(PG8_SA(0, 1), a2 + hstep, voffA);
            PG8_WAIT_V(8); PG8_WAIT_L(0); PG8_BAR; PG8_MMA(0, 0, At, B0); PG8_MMA(0, 1, At, B1); PG8_BAR; PG8_SCHED;
            PG8_LDA(At, 1, 1); PG8_STAGE(PG8_SB(1, 0), b3, voffB); PG8_STAGE(PG8_SB(1, 1), b3 + hstep, voffB); PG8_STAGE(PG8_SA(1, 0), a3, voffA);
            PG8_WAIT_V(8); PG8_WAIT_L(0); PG8_BAR; PG8_MMA(1, 0, At, B0); PG8_MMA(1, 1, At, B1); PG8_BAR; PG8_SCHED;
            } else {
            PG8_LDB(B0, 0, 0); PG8_SCHED; PG8_LDA(At, 0, 0); PG8_STAGE(PG8_SA(1, 1), a1 + hstep, voffA);
            PG8_WAIT_L(8); PG8_BAR; PG8_WAIT_L(0); PG8_MMA(0, 0, At, B0); PG8_BAR; PG8_SCHED;
            PG8_LDB(B1, 0, 1); PG8_STAGE(PG8_SB(0, 0), b2, voffB);
            PG8_BAR; PG8_WAIT_L(0); PG8_MMA(0, 1, At, B1); PG8_BAR;
            PG8_LDA(At, 0, 1); PG8_STAGE(PG8_SA(0, 0), a2, voffA);
            PG8_BAR; PG8_WAIT_L(0); PG8_MMA(1, 0, At, B0); PG8_BAR; PG8_SCHED;
            PG8_STAGE(PG8_SB(0, 1), b2 + hstep, voffB);
            PG8_WAIT_V(6); PG8_BAR; PG8_MMA(1, 1, At, B1); PG8_BAR;
            PG8_LDB(B0, 1, 0); PG8_SCHED; PG8_LDA(At, 1, 0); PG8_STAGE(PG8_SA(0, 1), a2 + hstep, voffA);
            PG8_WAIT_L(8); PG8_BAR; PG8_WAIT_L(0); PG8_MMA(0, 0, At, B0); PG8_BAR; PG8_SCHED;
            PG8_LDB(B1, 1, 1); PG8_STAGE(PG8_SB(1, 0), b3, voffB);
            PG8_BAR; PG8_WAIT_L(0); PG8_MMA(0, 1, At, B1); PG8_BAR;
            PG8_LDA(At, 1, 1); PG8_STAGE(PG8_SA(1, 0), a3, voffA);
            PG8_BAR; PG8_WAIT_L(0); PG8_MMA(1, 0, At, B0); PG8_BAR; PG8_SCHED;
            PG8_STAGE(PG8_SB(1, 1), b3 + hstep, voffB);
            PG8_WAIT_V(6); PG8_BAR; PG8_MMA(1, 1, At, B1); PG8_BAR;
            }
        }
        if constexpr (ALIGN_EPI) { if (wr == 0) PG8_BAR; }
        if constexpr (!Epi::AFTER_DRAIN) { E(acc, cur, wr, wc, fr, fq); S.done(cur); }
        if (!has_next) break;
#pragma unroll
        for (int a = 0; a < 2; ++a)
#pragma unroll
            for (int b = 0; b < 2; ++b)
#pragma unroll
                for (int m = 0; m < 4; ++m)
#pragma unroll
                    for (int n = 0; n < 2; ++n) acc[a][b][m][n] = (f32x4){0.f, 0.f, 0.f, 0.f};
        cur = nxt; cA = nA; cB = nB; ++ui;
        if constexpr (ALIGN_EPI) { if (wr == 1) PG8_BAR; }
    }
    PG8_WAIT_V(0);
    if constexpr (!ALIGN_EPI) { if (wr == 0) PG8_BAR; }
    PG8_BAR;
    if constexpr (Epi::AFTER_DRAIN) { E.fused(acc, cur, wr, wc, fr, fq, lds, wid, lane); S.done(cur); }
#undef PG8_SA
#undef PG8_SB
#undef PG8_STAGE
#undef PG8_LDA
#undef PG8_LDB
#undef PG8_MMA
#undef PG8_WAIT_V
#undef PG8_WAIT_L
#undef PG8_BAR
#undef PG8_SCHED
}
}
namespace att {
constexpr float SCALE = 0.08838834764831845f, THR = 8.f;
constexpr int NW = 8, QBLK = 32, KVBLK = 64, QB = NW * QBLK, D = 128, PITCH = 2048;
constexpr int SHM_V = KVBLK * D * 2, SHM_K = KVBLK * D * 2;
constexpr int LDS_BYTES = 2 * SHM_V + 2 * SHM_K + NW * 64 * 4;
using bf16 = __hip_bfloat16;
typedef short bf16x8 __attribute__((ext_vector_type(8)));
typedef short s16x4 __attribute__((ext_vector_type(4)));
typedef float f32x16 __attribute__((ext_vector_type(16)));
typedef float f32x4 __attribute__((ext_vector_type(4)));
typedef unsigned u32x4 __attribute__((ext_vector_type(4)));
template <class A, class Bt> struct same_t { static constexpr bool v = false; };
template <class A> struct same_t<A, A> { static constexpr bool v = true; };

#define KSWZ(row, colB) ((row) * 256 + ((colB) ^ (((row) & 7) << 4)))
#define SBAR() __builtin_amdgcn_sched_barrier(0)
__device__ __forceinline__ int v_st(int k, int c) { const int kk = (k & ~0xC) | ((k & 4) << 1) | ((k & 8) >> 1); return ((kk >> 3) * 4 + (c >> 5)) * 512 + ((kk & 7) * 32 + (c & 31)) * 2; }
__device__ __forceinline__ int v_rd_base(int lane) { return ((lane & 3) << 3) | (((lane >> 2) & 3) << 6) | (((lane >> 4) & 1) << 5) | (((lane >> 5) & 1) << 8); }
constexpr int v_rd_off(int d0, int ks, int half) { return d0 * 512 + ks * 4096 + half * 2048; }
__device__ __forceinline__ int crow(int r, int hi) { return (r & 3) + 8 * (r >> 2) + 4 * hi; }
__device__ __forceinline__ unsigned cvtpk(float lo, float hi) {
    unsigned r; asm volatile("v_cvt_pk_bf16_f32 %0, %1, %2" : "=v"(r) : "v"(lo), "v"(hi)); return r;
}
__device__ __forceinline__ bf16x8 pack8(f32x4 a, f32x4 b) {
    u32x4 w = {cvtpk(a[0], a[1]), cvtpk(a[2], a[3]), cvtpk(b[0], b[1]), cvtpk(b[2], b[3])};
    return *reinterpret_cast<bf16x8*>(&w);
}
template <class T> __device__ __forceinline__ bf16x8 load8(const T* p) {
    if constexpr (same_t<T, float>::v) { return pack8(*(const f32x4*)p, *(const f32x4*)(p + 4)); }
    else { return *reinterpret_cast<const bf16x8*>(p); }
}
__device__ __forceinline__ void mask_tile(f32x16& p0, f32x16& p1, int dq, unsigned W) {
    const float NEG = -__builtin_inff();
#pragma unroll
    for (int r = 0; r < 16; ++r) {
        const int c = (r & 3) + 8 * (r >> 2);
        if ((unsigned)(dq - c) >= W) p0[r] = NEG;
        if ((unsigned)(dq - c - 32) >= W) p1[r] = NEG;
    }
}
__device__ __forceinline__ void partialSM(f32x16& p0, f32x16& p1, float& m_reg, float& mn, float& alpha) {
    float pmax;
    {
#define MX3_(a, b, c) __builtin_fmaxf(__builtin_fmaxf((a), (b)), (c))
      float a = MX3_(p0[0], p0[1], p1[0]), b = MX3_(p0[2], p0[3], p1[1]); a = MX3_(a, p1[2], p1[3]);
#pragma unroll
      for (int r = 4; r < 16; r += 4) { a = MX3_(a, p0[r], p0[r + 1]); b = MX3_(b, p0[r + 2], p0[r + 3]); a = MX3_(a, p1[r], p1[r + 1]); b = MX3_(b, p1[r + 2], p1[r + 3]); }
      pmax = __builtin_fmaxf(a, b);
#undef MX3_
    }
    { auto rr = __builtin_amdgcn_permlane32_swap(__float_as_uint(pmax), __float_as_uint(pmax), false, false);
      pmax = fmaxf(__uint_as_float(rr[0]), __uint_as_float(rr[1])); }
    constexpr float C2 = 1.4426950408889634f * SCALE;
    if (__builtin_expect(__all((pmax - m_reg) * SCALE <= THR), 1)) { mn = m_reg; alpha = 1.f; }
    else { mn = fmaxf(m_reg, pmax); alpha = __builtin_amdgcn_exp2f((m_reg - mn) * C2); m_reg = mn; }
    const float mnL = -mn * C2;
    for (int r = 0; r < 16; ++r) p0[r] = fmaf(p0[r], C2, mnL); for (int r = 0; r < 16; ++r) p1[r] = fmaf(p1[r], C2, mnL);
    for (int r = 0; r < 16; ++r) p0[r] = __builtin_amdgcn_exp2f(p0[r]);
}
__device__ __forceinline__ void finishSM(f32x16& p0, f32x16& p1, float alpha, float& l_reg, bf16x8& pa0, bf16x8& pa1, bf16x8& pa2, bf16x8& pa3) {
    for (int r = 0; r < 16; ++r) p1[r] = __builtin_amdgcn_exp2f(p1[r]);
    float ps;
    {
      float s0 = p0[0] + p1[0], s1 = p0[1] + p1[1], s2 = p0[2] + p1[2], s3 = p0[3] + p1[3];
#pragma unroll
      for (int r = 4; r < 16; r += 4) { s0 += p0[r]; s1 += p0[r + 1]; s2 += p0[r + 2]; s3 += p0[r + 3]; s0 += p1[r]; s1 += p1[r + 1]; s2 += p1[r + 2]; s3 += p1[r + 3]; }
      ps = (s0 + s1) + (s2 + s3); }
    { auto rr = __builtin_amdgcn_permlane32_swap(__float_as_uint(ps), __float_as_uint(ps), false, false);
      ps = __uint_as_float(rr[0]) + __uint_as_float(rr[1]); }
    l_reg = l_reg * alpha + ps;
#define PK4(P, B_, OUT) do { unsigned a0 = cvtpk(P[B_+0], P[B_+1]), a1 = cvtpk(P[B_+2], P[B_+3]);                          \
        unsigned b0 = cvtpk(P[B_+4], P[B_+5]), b1 = cvtpk(P[B_+6], P[B_+7]);                                             \
        auto r0 = __builtin_amdgcn_permlane32_swap(a0, b0, false, false); auto r1 = __builtin_amdgcn_permlane32_swap(a1, b1, false, false); \
        u32x4 w = {r0[0], r1[0], r0[1], r1[1]}; OUT = *reinterpret_cast<bf16x8*>(&w); } while (0)
    PK4(p0, 0, pa0); PK4(p0, 8, pa1); PK4(p1, 0, pa2); PK4(p1, 8, pa3);
#undef PK4
}
template <int KB, bool SK>
__device__ __forceinline__ void qkt(f32x16& p0, f32x16& p1, const char* K_lds, int r32, int hi, const bf16x8* qr, bool act) {
    if (SK && !act) { const float NEG = -__builtin_inff();
#pragma unroll
        for (int r = 0; r < 16; ++r) { p0[r] = NEG; p1[r] = NEG; } return; }
    p0 = f32x16{}; p1 = f32x16{};
    const char* kb[4];
#pragma unroll
    for (int dd = 0; dd < 4; ++dd) kb[dd] = K_lds + KB * SHM_K + KSWZ(r32, (dd * 16 + hi * 8) * 2);
#pragma unroll
    for (int d0 = 0; d0 < 8; ++d0) { const char* a = kb[d0 & 3] + (d0 >> 2) * 128;
        bf16x8 b0 = *reinterpret_cast<const bf16x8*>(a);
        bf16x8 b1 = *reinterpret_cast<const bf16x8*>(a + 32 * 256);
        p0 = __builtin_amdgcn_mfma_f32_32x32x16_bf16(b0, qr[d0], p0, 0, 0, 0);
        p1 = __builtin_amdgcn_mfma_f32_32x32x16_bf16(b1, qr[d0], p1, 0, 0, 0); }
}
template <int VB, bool SK>
__device__ __forceinline__ void pv_tile(f32x16* o, int vb0, bf16x8 pa0, bf16x8 pa1, bf16x8 pa2, bf16x8 pa3, bool act) {
    if (SK && !act) return;
#define TRRD(dst, off) asm volatile("ds_read_b64_tr_b16 %0, %1 offset:%2" : "=&v"(dst) : "v"(vb0), "i"(off) : "memory")
#define PV_D0(d0) do { s16x4 l0, l1, l2, l3, h0, h1, h2, h3; constexpr int b_ = VB * SHM_V + v_rd_off(d0, 0, 0);     \
        TRRD(l0, b_); TRRD(h0, b_ + 2048); TRRD(l1, b_ + 4096); TRRD(h1, b_ + 6144); TRRD(l2, b_ + 8192); TRRD(h2, b_ + 10240); TRRD(l3, b_ + 12288); TRRD(h3, b_ + 14336); \
        asm volatile("s_waitcnt lgkmcnt(0)" ::: "memory"); SBAR();                 \
        o[d0] = __builtin_amdgcn_mfma_f32_32x32x16_bf16(pa0, (bf16x8){l0[0], l0[1], l0[2], l0[3], h0[0], h0[1], h0[2], h0[3]}, o[d0], 0, 0, 0);   \
        o[d0] = __builtin_amdgcn_mfma_f32_32x32x16_bf16(pa1, (bf16x8){l1[0], l1[1], l1[2], l1[3], h1[0], h1[1], h1[2], h1[3]}, o[d0], 0, 0, 0);   \
        o[d0] = __builtin_amdgcn_mfma_f32_32x32x16_bf16(pa2, (bf16x8){l2[0], l2[1], l2[2], l2[3], h2[0], h2[1], h2[2], h2[3]}, o[d0], 0, 0, 0);   \
        o[d0] = __builtin_amdgcn_mfma_f32_32x32x16_bf16(pa3, (bf16x8){l3[0], l3[1], l3[2], l3[3], h3[0], h3[1], h3[2], h3[3]}, o[d0], 0, 0, 0); } while (0)
    PV_D0(0); PV_D0(1); PV_D0(2); PV_D0(3);
#undef PV_D0
#undef TRRD
}
struct BlockRef { const bf16* Q; const bf16* K; const bf16* V; bf16* O; int P0; };
struct Seam { bf16x8 qr[8]; bf16x8 st_v0, st_v1, st_k0, st_k1; };
#define ROW(p, k0, rr) ((p) + (size_t)((k0) + (rr)) * PITCH + sc)
#define VMW() asm volatile("s_waitcnt vmcnt(0)" ::: "memory")
#define VMWN(n) asm volatile("s_waitcnt vmcnt(%0)" :: "i"(n) : "memory")
#define SLOAD_H(Kp, Vp, k0) do { S.st_v0 = load8<bf16>(ROW(Vp, k0, sr)); S.st_v1 = load8<bf16>(ROW(Vp, k0, 32 + sr));              \
                         S.st_k0 = load8<bf16>(ROW(Kp, k0, sr)); S.st_k1 = load8<bf16>(ROW(Kp, k0, 32 + sr)); } while (0)
#define SWRITE_HK(bf) do { *(bf16x8*)(K_lds + (bf) * SHM_K + kws) = S.st_k0; *(bf16x8*)(K_lds + (bf) * SHM_K + kws + 32 * 256) = S.st_k1; } while (0)
#define SWRITE_HV(bf) do { *(bf16x8*)(V_lds + (bf) * SHM_V + vst0) = S.st_v0; *(bf16x8*)(V_lds + (bf) * SHM_V + vst1) = S.st_v1; } while (0)
#define SWRITE_H(bf) do { SWRITE_HV(bf); SWRITE_HK(bf); } while (0)
__device__ __forceinline__ void prime(const BlockRef& cur, char* lds, Seam& S) {
    const int tid = threadIdx.x, wid = __builtin_amdgcn_readfirstlane(tid >> 6), lane = tid & 63, r32 = lane & 31, hi = lane >> 5;
    const int sr = tid >> 4, sc = (tid & 15) * 8, kws = KSWZ(sr, sc * 2); char* K_lds = lds + 2 * SHM_V;
#pragma unroll
    for (int d0 = 0; d0 < 8; ++d0) S.qr[d0] = load8<bf16>(cur.Q + (size_t)(wid * QBLK + r32) * PITCH + d0 * 16 + hi * 8);
    SLOAD_H(cur.K, cur.V, 0); VMW(); SWRITE_HK(0);
    __syncthreads();
}
__device__ __forceinline__ void block(const BlockRef& cur, const BlockRef& nxt, int skv, char* lds, Seam& S) {
    const int W = 1 << 30;
    const int tid = threadIdx.x, wid = __builtin_amdgcn_readfirstlane(tid >> 6), lane = tid & 63, r32 = lane & 31, hi = lane >> 5;
    const int j_lo = 0;
    int j_hi = (cur.P0 + QB - 1) / KVBLK + 1; if (j_hi > skv / KVBLK) j_hi = skv / KVBLK;
    const int NT = j_hi - j_lo;
    const int kbn = 0;
    const int qlo = cur.P0 + wid * QBLK, qm = qlo + r32 - 4 * hi;
    char* V_lds = lds; char* K_lds = lds + 2 * SHM_V;
    float* ws = (float*)(lds + 2 * SHM_V + 2 * SHM_K) + wid * 64; float* li_l = ws, * al_l = ws + 32;
    float m_reg = -1e30f, l_reg = 0; f32x16 o[4] = {};
    const int sr = tid >> 4, sc = (tid & 15) * 8, vst0 = v_st(sr, sc), vst1 = v_st(32 + sr, sc), kws = KSWZ(sr, sc * 2);
    const int vb0 = (int)(uintptr_t)V_lds + v_rd_base(lane);
    const bf16* Kh = cur.K; const bf16* Vh = cur.V;
#define RESC(a) do { if (__any((a) < 1.f)) { if (hi == 0) al_l[r32] = (a); asm volatile("s_waitcnt lgkmcnt(0)" ::: "memory");              \
                     for (int d_ = 0; d_ < 4; ++d_) for (int r = 0; r < 16; ++r) o[d_][r] *= al_l[crow(r, hi)]; } } while (0)
#define KBASE(t) ((j_lo + (t)) * KVBLK)
#define ACT(t) (KBASE(t) <= qlo + QBLK - 1 && KBASE(t) + KVBLK - 1 >= qlo - W + 1)
#define MASKT(P0_, P1_, t) do { const int kb_ = KBASE(t); if ((!SK || ACT(t)) && (kb_ + KVBLK - 1 > qlo || kb_ <= qlo + QBLK - 1 - W)) mask_tile(P0_, P1_, qm - kb_, (unsigned)W); } while (0)
    constexpr int NQL = 8;
    constexpr bool SK = false;
#define SEAM_K0() do { VMWN(NQL); SWRITE_HK(0); SBAR(); } while (0)
    f32x16 pA0, pA1, pB0, pB1; float mnA, mnB, alA, alB; bf16x8 pa0, pa1, pa2, pa3;
    SWRITE_HV(0); SBAR();
    if (NT > 1) { SLOAD_H(Kh, Vh, KBASE(1)); }
    SBAR(); qkt<0, SK>(pA0, pA1, K_lds, r32, hi, S.qr, ACT(0));
    MASKT(pA0, pA1, 0); partialSM(pA0, pA1, m_reg, mnA, alA);
    if (NT > 1) { VMW(); SWRITE_H(1); }
    __syncthreads();
#define HALF_STEP(PX0, PX1, mnX, alX, PY0, PY1, alY, t, KB, VB, SB) do {                                                      \
        SBAR(); qkt<KB, SK>(PX0, PX1, K_lds, r32, hi, S.qr, ACT(t));                                             \
        finishSM(PY0, PY1, alY, l_reg, pa0, pa1, pa2, pa3); SBAR();                                                           \
        if ((t) + 1 < NT) { SLOAD_H(Kh, Vh, KBASE((t) + 1)); SBAR(); }                                               \
        pv_tile<VB, SK>(o, vb0, pa0, pa1, pa2, pa3, ACT((t) - 1)); MASKT(PX0, PX1, (t)); partialSM(PX0, PX1, m_reg, mnX, alX);                                        \
        __syncthreads();                                                                                                      \
        if ((t) + 1 < NT) { VMW(); SWRITE_H(SB); }                                                                          \
        RESC(alX); __syncthreads(); } while (0)
    for (int t = 1; t + 1 < NT; t += 2) {
        HALF_STEP(pB0, pB1, mnB, alB, pA0, pA1, alA, t, 1, 0, 0);
        HALF_STEP(pA0, pA1, mnA, alA, pB0, pB1, alB, t + 1, 0, 1, 1);
    }
    const bool even = (NT & 1) == 0;
    if (even) { SBAR(); qkt<1, SK>(pB0, pB1, K_lds, r32, hi, S.qr, ACT(NT - 1)); SBAR(); }
    SLOAD_H(nxt.K, nxt.V, kbn); SBAR();
#pragma unroll
    for (int d0 = 0; d0 < 8; ++d0) S.qr[d0] = load8<bf16>(nxt.Q + (size_t)(wid * QBLK + r32) * PITCH + d0 * 16 + hi * 8);
    SBAR();
    finishSM(pA0, pA1, alA, l_reg, pa0, pa1, pa2, pa3); SBAR();
    pv_tile<0, SK>(o, vb0, pa0, pa1, pa2, pa3, ACT(even ? NT - 2 : NT - 1));
    if (even) { MASKT(pB0, pB1, NT - 1); partialSM(pB0, pB1, m_reg, mnB, alB); __syncthreads(); RESC(alB);
        finishSM(pB0, pB1, alB, l_reg, pa0, pa1, pa2, pa3); SBAR(); pv_tile<1, SK>(o, vb0, pa0, pa1, pa2, pa3, ACT(NT - 1)); }
    SBAR(); SEAM_K0();
    if (hi == 0) li_l[r32] = l_reg; asm volatile("s_waitcnt lgkmcnt(0)" ::: "memory");
    float rli[16];
#pragma unroll
    for (int r = 0; r < 16; ++r) rli[r] = __builtin_amdgcn_rcpf(li_l[crow(r, hi)]);
    bf16* Ow = cur.O + (size_t)(wid * QBLK) * PITCH;
#pragma unroll
    for (int r = 0; r < 16; ++r) { const int orow = crow(r, hi);
#pragma unroll
        for (int d0 = 0; d0 < 4; ++d0) { const float v = o[d0][r] * rli[r];
            const float vn = __shfl_xor(v, 1);
            if ((r32 & 1) == 0) *(unsigned*)(Ow + (size_t)orow * PITCH + d0 * 32 + r32) = cvtpk(v, vn); } }
    __syncthreads();
#undef RESC
#undef KBASE
#undef ACT
#undef MASKT
#undef SEAM_K0
#undef HALF_STEP
}
#undef ROW
#undef VMW
#undef VMWN
#undef SLOAD_H
#undef SWRITE_HK
#undef SWRITE_HV
#undef SWRITE_H
#undef SBAR
#undef KSWZ
}
#define LAS __attribute__((address_space(3)))
typedef unsigned short bf16_t;
typedef float f32x4 __attribute__((ext_vector_type(4)));
typedef float f32x16 __attribute__((ext_vector_type(16)));
typedef short bf16x8 __attribute__((ext_vector_type(8)));
typedef unsigned u32x4 __attribute__((ext_vector_type(4)));
typedef unsigned u32x2 __attribute__((ext_vector_type(2)));
constexpr int DM = 4096, TPAD = 4224, TVALID = 4112, NMETA = 16, MX = 8192, MIN_ROWS = 8448, INW = 10240, DFF = 11008, NGU = 22016, NCH = 65;
constexpr float EPS = 1e-6f, L2E = 1.4426950408889634f;
constexpr size_t MiB = 1u << 20;
constexpr size_t WS_WIN = 16 * MiB, WS_WOUT = 96 * MiB, WS_WGU = 128 * MiB, WS_WDN = 300 * MiB, WS_SMALL = 386 * MiB, WS_R1 = 400 * MiB, WS_R2 = 466 * MiB, WS_R3 = 638 * MiB, WS_R4 = 770 * MiB, WS_END = 834 * MiB;
constexpr size_t SM_COS = 0, SM_SIN = 2 * MiB, SM_WTR = 4 * MiB, SM_WTI = 4 * MiB + 512 * 1024, SM_SPL = 5 * MiB, SM_SSQ1 = 6 * MiB, SM_SSQ2 = 8 * MiB, SM_AAGG = 10 * MiB, SM_BAGG = 12 * MiB;
constexpr size_t QKV_ELEMS = (size_t)2 * TPAD * 2048;
constexpr int LDS_BYTES = 147456;
constexpr int NPHASE = 9;
constexpr int WDN_EARLY = 4864;
#ifndef PROBE_REP
#define PROBE_REP -1
#endif
#ifndef PROBE_SUB
#define PROBE_SUB 0
#endif
#ifndef MK_N_LAUNCHES
#define MK_N_LAUNCHES 1
#endif

__device__ __forceinline__ float wave_sum(float v) {
#pragma unroll
    for (int o = 1; o < 64; o <<= 1) v += __shfl_xor(v, o);
    return v;
}
__device__ __forceinline__ unsigned pk2(float lo, float hi) { return pg8::cvt_pk_bf16(lo, hi); }
__device__ __forceinline__ float bf_lo(unsigned w) { return __uint_as_float(w << 16); }
__device__ __forceinline__ float bf_hi(unsigned w) { return __uint_as_float(w & 0xffff0000u); }
__device__ __forceinline__ float sigmoidf_(float x) { return __builtin_amdgcn_rcpf(1.f + __builtin_amdgcn_exp2f(-L2E * x)); }
__device__ __forceinline__ int crow16(int r, int hi) { return (r & 3) + 8 * (r >> 2) + 4 * hi; }

__device__ __forceinline__ int map_row(int mode, int n0) {
    if (mode == 1) { if (n0 < 4096) { const int g = (n0 >> 6) & 3, g2 = (g == 1) ? 2 : (g == 2) ? 1 : g; return (n0 & ~255) + (g2 << 6) + (n0 & 63); } return n0; }
    if (mode == 2) return ((n0 >> 7) << 8) + (n0 & 127);
    if (mode == 3) return ((n0 >> 7) << 8) + 128 + (n0 & 127);
    return n0;
}
__device__ __forceinline__ void transpose_item(const float* __restrict__ W, int K, int N, bf16_t* __restrict__ WT, int mode, LAS float* scr, int item, int lane) {
    const int nblk = N / 64, kb = item / nblk, nb = item % nblk, k0 = 64 * kb, n0 = 64 * nb;
    const int rbase = map_row(mode, n0), l15 = lane & 15, lq = lane >> 4;
    const float* src = W + (size_t)(k0 + lq) * N + n0 + 4 * l15;
    f32x4 v[16];
#pragma unroll
    for (int i = 0; i < 16; ++i) v[i] = __builtin_nontemporal_load((const f32x4*)(src + (size_t)(4 * i) * N));
#pragma unroll
    for (int i = 0; i < 16; ++i) { LAS float* d = scr + (4 * i + lq) * 65 + 4 * l15; d[0] = v[i][0]; d[1] = v[i][1]; d[2] = v[i][2]; d[3] = v[i][3]; }
    asm volatile("s_waitcnt lgkmcnt(0)" ::: "memory");
    const int c = lane & 7, nr = lane >> 3;
#pragma unroll
    for (int j = 0; j < 8; ++j) { const int n = nr + 8 * j; const LAS float* s = scr + (8 * c) * 65 + n;
        u32x4 o; o.x = pk2(s[0 * 65], s[1 * 65]); o.y = pk2(s[2 * 65], s[3 * 65]); o.z = pk2(s[4 * 65], s[5 * 65]); o.w = pk2(s[6 * 65], s[7 * 65]);
        *(u32x4*)(WT + (size_t)(rbase + n) * K + k0 + 8 * c) = o; }
    asm volatile("s_waitcnt lgkmcnt(0)" ::: "memory");
}
template <int K, int N> __device__ __forceinline__ void tr_load(const float* __restrict__ W, int item, int lane, f32x4 (&v)[16], const float* __restrict__ gs = nullptr) {
    constexpr int nblk = N / 64; const int kb = item / nblk, nb = item % nblk;
    const float* src = W + (size_t)(64 * kb + (lane >> 4)) * N + 64 * nb + 4 * (lane & 15);
#pragma unroll
    for (int i = 0; i < 16; ++i) v[i] = __builtin_nontemporal_load((const f32x4*)(src + (size_t)(4 * i) * N));
    if (gs) {
        float sc[16];
#pragma unroll
        for (int i = 0; i < 16; ++i) sc[i] = gs[64 * kb + 4 * i + (lane >> 4)];
#pragma unroll
        for (int i = 0; i < 16; ++i) v[i] = v[i] * sc[i];
    }
}
template <int K, int N> __device__ __forceinline__ void tr_store(bf16_t* __restrict__ WT, int mode, LAS float* scr, int item, int lane, const f32x4 (&v)[16]) {
    constexpr int nblk = N / 64; const int kb = item / nblk, nb = item % nblk, k0 = 64 * kb, l15 = lane & 15, lq = lane >> 4;
    const int rbase = map_row(mode, 64 * nb);
#pragma unroll
    for (int i = 0; i < 16; ++i) { LAS float* d = scr + (4 * i + lq) * 65 + 4 * l15; d[0] = v[i][0]; d[1] = v[i][1]; d[2] = v[i][2]; d[3] = v[i][3]; }
    asm volatile("s_waitcnt lgkmcnt(0)" ::: "memory");
    const int c = lane & 7, nr = lane >> 3;
#pragma unroll
    for (int j = 0; j < 8; ++j) { const int n = nr + 8 * j; const LAS float* sp = scr + (8 * c) * 65 + n;
        u32x4 o; o.x = pk2(sp[0 * 65], sp[1 * 65]); o.y = pk2(sp[2 * 65], sp[3 * 65]); o.z = pk2(sp[4 * 65], sp[5 * 65]); o.w = pk2(sp[6 * 65], sp[7 * 65]);
        *(u32x4*)(WT + (size_t)(rbase + n) * K + k0 + 8 * c) = o; }
    asm volatile("s_waitcnt lgkmcnt(0)" ::: "memory");
}
template <int K, int N> __device__ __forceinline__ void tr_run(const float* __restrict__ W1, const float* __restrict__ W2, int split, bf16_t* __restrict__ WT, int mode1, int mode2,
                                                               LAS float* scr, int first, int count, int stride, int lane, const float* __restrict__ gs = nullptr) {
    for (int it = first; it < count; it += 2 * stride) {
        const int itb = it + stride; const bool two = itb < count;
        f32x4 va[16], vb[16];
        tr_load<K, N>(it < split ? W1 : W2, it < split ? it : it - split, lane, va, gs);
        if (two) tr_load<K, N>(itb < split ? W1 : W2, itb < split ? itb : itb - split, lane, vb, gs);
        tr_store<K, N>(WT, it < split ? mode1 : mode2, scr, it < split ? it : it - split, lane, va);
        if (two) tr_store<K, N>(WT, itb < split ? mode1 : mode2, scr, itb < split ? itb : itb - split, lane, vb);
    }
}
__device__ __forceinline__ void rms_row_bf16(const float* __restrict__ xrow, const float* __restrict__ g, bf16_t* __restrict__ orow, int lane) {
    const f32x4* xr = (const f32x4*)xrow + lane; f32x4 v[16]; float s = 0.f;
#pragma unroll
    for (int j = 0; j < 16; ++j) { v[j] = __builtin_nontemporal_load(xr + 64 * j); s += (v[j][0] * v[j][0] + v[j][1] * v[j][1]) + (v[j][2] * v[j][2] + v[j][3] * v[j][3]); }
    const float rs = rsqrtf(wave_sum(s) * (1.f / DM) + EPS);
    const f32x4* gp = (const f32x4*)g + lane; u32x2* o8 = (u32x2*)orow + lane;
#pragma unroll
    for (int j = 0; j < 16; ++j) { const f32x4 gg = gp[64 * j]; u32x2 w; w.x = pk2(v[j][0] * rs * gg[0], v[j][1] * rs * gg[1]); w.y = pk2(v[j][2] * rs * gg[2], v[j][3] * rs * gg[3]); o8[64 * j] = w; }
}

#define XB_TMO      128
#define XB_XCNT(j)  (256  + 64 * (j))
#define XB_XSUB(j)  (1280 + 64 * (j))
#define XB_XGEN(j)  (2304 + 64 * (j))
#define XB_TOP      3328
#define XB_TOPGEN   3392
#define XCD_BAR_WORDS 3456
#define XB_SPIN_CAP (1u << 18)

__device__ __forceinline__ unsigned xb_ld(unsigned* p)              { return __hip_atomic_load(p, __ATOMIC_RELAXED, __HIP_MEMORY_SCOPE_AGENT); }
__device__ __forceinline__ unsigned xb_add(unsigned* p, unsigned v) { return __hip_atomic_fetch_add(p, v, __ATOMIC_RELAXED, __HIP_MEMORY_SCOPE_AGENT); }
__device__ __forceinline__ unsigned xb_xcc_id() { return (unsigned)__builtin_amdgcn_s_getreg((3 << 11) | 20) & 0xFu; }
#define XB_SPIN(cond, bar) do { unsigned _sp = 0; while (cond) { __builtin_amdgcn_s_sleep(1); \
    if ((++_sp & 255u) == 0u) { if (xb_ld(&(bar)[XB_TMO])) break; if (_sp > XB_SPIN_CAP) { atomicAdd(&(bar)[XB_TMO], 1u); break; } } } } while (0)

struct XcdBarrier {
    unsigned* bar; unsigned x;
    volatile LAS unsigned* st;
};

__device__ __forceinline__ XcdBarrier xcd_barrier_post(unsigned* bar, volatile LAS unsigned* st) {
    XcdBarrier b; b.bar = bar; b.x = xb_xcc_id(); b.st = st;
    if (threadIdx.x == 0) (void)xb_add(&bar[XB_XCNT(b.x)], 1u);
    return b;
}
__device__ __forceinline__ void xcd_barrier_complete(unsigned* bar, unsigned x, unsigned& nloc, unsigned& nx) {
    const unsigned G = gridDim.x * gridDim.y * gridDim.z;
    unsigned sum, cnt, mine, sp = 0u;
    for (;;) {
        sum = 0u; cnt = 0u; mine = 0u;
#pragma unroll
        for (unsigned j = 0; j < 16; ++j) { const unsigned c = xb_ld(&bar[XB_XCNT(j)]); sum += c; cnt += (c > 0u) ? 1u : 0u; mine = (j == x) ? c : mine; }
        if (sum == G) break;
        __builtin_amdgcn_s_sleep(1);
        if ((++sp & 255u) == 0u) { if (xb_ld(&bar[XB_TMO])) break; if (sp > XB_SPIN_CAP) { atomicAdd(&bar[XB_TMO], 1u); break; } }
    }
    nloc = mine > 0u ? mine : 1u; nx = cnt > 0u ? cnt : 1u;
}

__device__ __forceinline__ void xcd_barrier(const XcdBarrier& b) {
    asm volatile("s_waitcnt vmcnt(0)" ::: "memory");
    __syncthreads();
    if (threadIdx.x == 0) {
        unsigned* bar = b.bar;
        __builtin_amdgcn_s_waitcnt(0);
        unsigned nloc = b.st[0], nx = b.st[1];
        if (nloc == 0u) { xcd_barrier_complete(bar, b.x, nloc, nx); b.st[0] = nloc; b.st[1] = nx; }
        const unsigned old = xb_add(&bar[XB_XSUB(b.x)], 1u);
        const unsigned gen = old / nloc;
        if (old + 1u == (gen + 1u) * nloc) {
            __builtin_amdgcn_fence(__ATOMIC_RELEASE, "agent");
            asm volatile("s_waitcnt vmcnt(0)" ::: "memory");
            const unsigned og = xb_add(&bar[XB_TOP], 1u);
            const unsigned tg = og / nx;
            if (og + 1u == (tg + 1u) * nx) xb_add(&bar[XB_TOPGEN], 1u);
            else XB_SPIN(xb_ld(&bar[XB_TOPGEN]) == tg, bar);
            __builtin_amdgcn_fence(__ATOMIC_ACQUIRE, "agent");
            xb_add(&bar[XB_XGEN(b.x)], 1u);
            asm volatile("s_waitcnt vmcnt(0)" ::: "memory");
        } else {
            XB_SPIN(xb_ld(&bar[XB_XGEN(b.x)]) == gen, bar);
            __builtin_amdgcn_fence(__ATOMIC_ACQUIRE, "agent");
            asm volatile("s_waitcnt vmcnt(0)" ::: "memory");
        }
    }
    __syncthreads();
}

struct SubOrder { pg8::StaticOrder B; int i0, n;
    __device__ __forceinline__ bool next(int i, pg8::Unit& u) const { return i < n && B.next(i0 + i, u); }
    __device__ __forceinline__ void a_ready(const pg8::Unit&) const {}
    __device__ __forceinline__ void done(const pg8::Unit&) const {}
};
struct Params { const float* in[23]; float* out; unsigned char* ws; int ph_lo, ph_hi; };
typedef const __attribute__((address_space(4))) Params* KP;
__device__ __forceinline__ KP kargs() { KP q = (KP)__builtin_amdgcn_kernarg_segment_ptr(); asm volatile("" : "+s"(q)); return q; }

__global__ void __launch_bounds__(512, 2) fwd_mega(Params P_by_kernarg) {
    extern __shared__ __attribute__((aligned(16))) unsigned char lds[];
    cg::grid_group grid = cg::this_grid();
    const int tid = threadIdx.x, lane = tid & 63, wave = __builtin_amdgcn_readfirstlane(tid >> 6);
    const int G = gridDim.x, bx = blockIdx.x, vcu = (G % 8 == 0) ? (bx % 8) * (G / 8) + bx / 8 : bx;
    const int gw = vcu * 8 + wave, NGW = G * 8;
#define Win_t  ((bf16_t*)(ws + WS_WIN))
#define Wout_t ((bf16_t*)(ws + WS_WOUT))
#define Wgu_t  ((bf16_t*)(ws + WS_WGU))
#define Wdn_t  ((bf16_t*)(ws + WS_WDN))
#define cosT   ((float*)(ws + WS_SMALL + SM_COS))
#define sinT   ((float*)(ws + WS_SMALL + SM_SIN))
#define WTr    ((bf16_t*)(ws + WS_SMALL + SM_WTR))
#define WTi    ((bf16_t*)(ws + WS_SMALL + SM_WTI))
#define spl    ((float*)(ws + WS_SMALL + SM_SPL))
#define ssq1   ((float*)(ws + WS_SMALL + SM_SSQ1))
#define ssq2   ((float*)(ws + WS_SMALL + SM_SSQ2))
#define Aagg   ((float*)(ws + WS_SMALL + SM_AAGG))
#define Bagg   ((float*)(ws + WS_SMALL + SM_BAGG))
#define Ubuf   ((bf16_t*)(ws + WS_R1))
#define QKV    ((bf16_t*)(ws + WS_R2))
#define Qb     (QKV)
#define Kb     (QKV + QKV_ELEMS)
#define Vb     (QKV + 2 * QKV_ELEMS)
#define XRb    (QKV + 3 * QKV_ELEMS)
#define GTb    (QKV + 4 * QKV_ELEMS)
#define Pc     ((bf16_t*)(ws + WS_R3))
#define Hloc   ((bf16_t*)(ws + WS_R3) + QKV_ELEMS)
#define Mixed  ((bf16_t*)(ws + WS_R3))
#define Opart  ((bf16_t*)(ws + WS_R4))
#define H1b    ((bf16_t*)(ws + WS_R4))
#define RS2    ((float*)(ws + WS_SMALL + SM_SPL + 65536))
#define RS1    ((float*)(ws + WS_SMALL + SM_SPL + 131072))
    const int lo = kargs()->ph_lo, hi_ph = kargs()->ph_hi;
    volatile LAS unsigned* MISCW = (volatile LAS unsigned*)((LAS unsigned char*)lds + (LDS_BYTES - 256));
    const bool fast = (lo == 0 && hi_ph == NPHASE);
    unsigned* const barw = (unsigned*)(kargs()->ws + 4096);
    if (tid < 2) MISCW[tid] = 0u;
    __syncthreads();
    XcdBarrier xbar; xbar.bar = barw; xbar.x = 0; xbar.st = MISCW;
    if (fast) xbar = xcd_barrier_post(barw, MISCW);
#define IN(k) (lo <= (k) && (k) < hi_ph)
#define SEAM(k) do { if (IN(k) && IN((k) + 1)) { if (fast) xcd_barrier(xbar); else grid.sync(); } } while (0)

    if (IN(0)) {
        const KP KA = kargs(); unsigned char* const ws = KA->ws;
        LAS float* scr = (LAS float*)((LAS unsigned char*)lds + wave * 16640);
        constexpr int I_IN = 64 * 160;
        tr_run<DM, INW>(KA->in[3], KA->in[3], I_IN, Win_t, 1, 1, scr, gw, I_IN, NGW, lane, KA->in[2]);
        for (int m = gw; m < MX + NMETA; m += NGW) {
            const float* xrow = (m < MX) ? KA->in[0] + (size_t)m * DM : KA->in[1] + (size_t)(m - MX) * DM;
            const f32x4* xr = (const f32x4*)xrow + lane; f32x4 v[16]; float sq = 0.f;
#pragma unroll
            for (int j = 0; j < 16; ++j) { v[j] = __builtin_nontemporal_load(xr + 64 * j); sq += (v[j][0] * v[j][0] + v[j][1] * v[j][1]) + (v[j][2] * v[j][2] + v[j][3] * v[j][3]); }
            const float rs = rsqrtf(wave_sum(sq) * (1.f / DM) + EPS); if (lane == 0) RS1[m] = rs;
            u32x2* o8 = (u32x2*)(Ubuf + (size_t)m * DM) + lane;
#pragma unroll
            for (int j = 0; j < 16; ++j) { u32x2 w; w.x = pk2(v[j][0], v[j][1]); w.y = pk2(v[j][2], v[j][3]); o8[64 * j] = w; }
        }
        const int gt = vcu * 512 + tid, NGT = G * 512;
        for (int idx = gt; idx < TPAD * 64; idx += NGT) {
            const int pos = idx >> 6, i = idx & 63;
            const float inv = exp2f(-(float)i * (13.287712379549449f / 64.f));
            double rev = (double)pos * (double)inv * 0.15915494309189535; rev -= __builtin_floor(rev);
            cosT[idx] = __builtin_amdgcn_cosf((float)rev); sinT[idx] = __builtin_amdgcn_sinf((float)rev);
        }
        for (int o = gt; o < 2 * 16 * 128 * 128; o += NGT) {
            const int which = o >> 18, oo = o & 262143, hd = oo >> 14, j = (oo >> 7) & 127, i = oo & 127;
            const float v = (which ? KA->in[13] : KA->in[11])[(hd << 14) + (i << 7) + j];
            (which ? WTi : WTr)[oo] = (bf16_t)(pk2(v, 0.f) & 0xffffu);
        }
        for (int c = gt; c < 2048; c += NGT) { const float lam = KA->in[15][c]; const float sp = (lam > 15.f) ? expf(-lam) : log1pf(expf(-lam)); spl[c] = 8.f * sp * L2E; }
        { constexpr int PADROWS = TPAD - TVALID, CH16 = 2048 / 8;
          for (int idx = gt; idx < 5 * 2 * PADROWS * CH16; idx += NGT) { const int ch = idx % CH16, rr = idx / CH16, prow = rr % PADROWS, bb = (rr / PADROWS) & 1, buf = rr / (2 * PADROWS);
              *(u32x4*)(QKV + (size_t)buf * QKV_ELEMS + ((size_t)(bb * TPAD + TVALID + prow)) * 2048 + ch * 8) = (u32x4){0u, 0u, 0u, 0u}; } }
    }
    SEAM(0);
    if (IN(1)) {
        const KP KA = kargs(); unsigned char* const ws = KA->ws;
        if (vcu < 160) {
            const int kq = wave & 3, item = vcu * 2 + (wave >> 2), pn = item >> 3, jg = item & 7, l15 = lane & 15, fq = lane >> 4;
            const bf16_t* b0p = Win_t + ((size_t)(pn * 256 + jg * 16 + l15)) * DM + kq * 1024 + fq * 8; const bf16_t* b1p = b0p + (size_t)128 * DM;
            const bf16_t* ap = Ubuf + ((size_t)(MX + l15)) * DM + kq * 1024 + fq * 8;
            f32x4 c0 = (f32x4){0.f, 0.f, 0.f, 0.f}, c1 = c0;
#pragma unroll 8
            for (int ks = 0; ks < 32; ++ks) { const bf16x8 w0 = *(const bf16x8*)(b0p + ks * 32), w1 = *(const bf16x8*)(b1p + ks * 32), av = *(const bf16x8*)(ap + ks * 32);
                c0 = __builtin_amdgcn_mfma_f32_16x16x32_bf16(w0, av, c0, 0, 0, 0); c1 = __builtin_amdgcn_mfma_f32_16x16x32_bf16(w1, av, c1, 0, 0, 0); }
            LAS f32x4* red = (LAS f32x4*)lds;
            red[(wave * 2 + 0) * 64 + lane] = c0; red[(wave * 2 + 1) * 64 + lane] = c1;
            __syncthreads();
            if (kq == 0) {
#pragma unroll
                for (int q = 1; q < 4; ++q) { c0 += red[((wave + q) * 2 + 0) * 64 + lane]; c1 += red[((wave + q) * 2 + 1) * 64 + lane]; }
                { const float rr = RS1[MX + l15]; c0 = c0 * rr; c1 = c1 * rr; }
                const int sect = pn >> 3, hd = pn & 7, pos = l15, j = jg * 16 + 4 * fq;
                bf16_t* buf = QKV + (size_t)sect * QKV_ELEMS + (size_t)pos * 2048 + hd * 256;
                if (sect < 2) { const int comp = j >> 6, i0 = j & 63;
                    const f32x4 cs = *(const f32x4*)(cosT + pos * 64 + i0), sn = *(const f32x4*)(sinT + pos * 64 + i0);
                    const f32x4 o1 = c0 * cs - c1 * sn, o2 = c1 * cs + c0 * sn;
                    u32x2 w1, w2; w1.x = pk2(o1[0], o1[1]); w1.y = pk2(o1[2], o1[3]); w2.x = pk2(o2[0], o2[1]); w2.y = pk2(o2[2], o2[3]);
                    bf16_t* p = buf + comp * 128 + i0;
                    *(u32x2*)p = w1; *(u32x2*)(p + 64) = w2; *(u32x2*)(p + (size_t)TPAD * 2048) = w1; *(u32x2*)(p + (size_t)TPAD * 2048 + 64) = w2;
                } else { u32x2 w1, w2; w1.x = pk2(c0[0], c0[1]); w1.y = pk2(c0[2], c0[3]); w2.x = pk2(c1[0], c1[1]); w2.y = pk2(c1[2], c1[3]);
                    bf16_t* p = buf + j;
                    *(u32x2*)p = w1; *(u32x2*)(p + 128) = w2; *(u32x2*)(p + (size_t)TPAD * 2048) = w1; *(u32x2*)(p + (size_t)TPAD * 2048 + 128) = w2; }
            }
            __syncthreads();
        }
        pg8::Gemm g{Ubuf, Win_t, MX, INW, DM}; pg8::StaticOrder S0; S0.init(MX, INW, G, bx);
        pg8::EpiIn E{QKV, cosT, sinT, RS1};
        const int NU = (S0.nwg + G - 1) / G, cls = bx % NU;
        { SubOrder S{S0, 0, cls}; pg8::gemm_phase<pg8::EpiIn, SubOrder, true, true>((LAS unsigned char*)lds, g, S, E); }
        {
            __syncthreads();
            const KP KA = kargs(); unsigned char* const ws = KA->ws;
            LAS float* scr = (LAS float*)((LAS unsigned char*)lds + wave * 16640);
            constexpr int I_OUT = 64 * 64, I_G = 64 * 172, I_D = WDN_EARLY, NDEF = I_OUT + 2 * I_G + I_D;
            (void)NDEF;
            tr_run<DM, DM>(KA->in[16], KA->in[16], I_OUT, Wout_t, 0, 0, scr, gw, I_OUT, NGW, lane);
            tr_run<DM, DFF>(KA->in[19], KA->in[20], I_G, Wgu_t, 2, 3, scr, gw, 2 * I_G, NGW, lane, KA->in[18]);
            if (I_D > 0) tr_run<DFF, DM>(KA->in[21], KA->in[21], I_D, Wdn_t, 0, 0, scr, gw, I_D, NGW, lane);
            __syncthreads();
        }
        { const KP KA = kargs(); unsigned char* const ws = KA->ws;
          pg8::Gemm g2{Ubuf, Win_t, MX, INW, DM}; pg8::StaticOrder S1; S1.init(MX, INW, G, bx); pg8::EpiIn E2{QKV, cosT, sinT, RS1};
          SubOrder S{S1, cls, NU - cls}; pg8::gemm_phase<pg8::EpiIn, SubOrder, true, true>((LAS unsigned char*)lds, g2, S, E2); }
    }
    SEAM(1);
    if (IN(2)) {
        const KP KA = kargs(); unsigned char* const ws = KA->ws;
        LAS bf16_t* XB = (LAS bf16_t*)lds;
        LAS float* A_s = (LAS float*)((LAS unsigned char*)lds + 17408); LAS float* B_s = A_s + 64 * 129;
        LAS float* PAR = (LAS float*)((LAS unsigned char*)lds + 83456); LAS float* SEG = PAR + 1024;
#define LDS_BAR() asm volatile("s_waitcnt lgkmcnt(0)\n\ts_barrier" ::: "memory")
        {
        const int chg = tid & 15, rg = tid >> 4, tt = wave & 1, jt = wave >> 1, l31 = lane & 31, hi = lane >> 5;
        int loaded_hd = -1; bf16x8 wrf[8], wif[8]; u32x4 xw[5];
#define LRU_LOADX(it_) do { const int hd_ = (it_) & 15, bc_ = (it_) >> 4, c_ = bc_ % NCH, b_ = bc_ / NCH; _Pragma("unroll") for (int k = 0; k < 5; ++k) { const int pos = c_ * 64 + 2 * rg - 3 + k; \
            xw[k] = (u32x4){0u, 0u, 0u, 0u}; if (pos >= 0) xw[k] = *(const u32x4*)(XRb + ((size_t)(b_ * TPAD + pos)) * 2048 + hd_ * 128 + chg * 8); } } while (0)
        for (int rep_ = 0; rep_ < (PROBE_SUB == 1 ? 2 : 1); ++rep_) {
        if (vcu < 2 * NCH * 16) LRU_LOADX(vcu);
        for (int item = vcu; item < 2 * NCH * 16; item += G) {
            const int hd = item & 15, bc = item >> 4, c64 = bc % NCH, b = bc / NCH, t0 = c64 * 64;
            if (hd != loaded_hd) {
                __syncthreads();
                for (int i = tid; i < 1024; i += 512) { const int k = i >> 7, j = i & 127; float v;
                    if (k < 4) v = KA->in[9][k * 2048 + hd * 128 + j]; else if (k == 4) v = KA->in[10][hd * 128 + j]; else if (k == 5) v = KA->in[12][hd * 128 + j]; else if (k == 6) v = KA->in[14][hd * 128 + j]; else v = spl[hd * 128 + j];
                    PAR[i] = v; }
                const bf16_t* wrp = WTr + ((size_t)(hd * 128 + jt * 32 + l31)) * 128 + hi * 8; const bf16_t* wip = WTi + ((size_t)(hd * 128 + jt * 32 + l31)) * 128 + hi * 8;
#pragma unroll
                for (int kk = 0; kk < 8; ++kk) { wrf[kk] = *(const bf16x8*)(wrp + kk * 16); wif[kk] = *(const bf16x8*)(wip + kk * 16); }
                loaded_hd = hd;
                __syncthreads();
            }
            { float xin[5][8];
#pragma unroll
              for (int k = 0; k < 5; ++k) { const u32x4 w = xw[k];
                  xin[k][0] = bf_lo(w.x); xin[k][1] = bf_hi(w.x); xin[k][2] = bf_lo(w.y); xin[k][3] = bf_hi(w.y); xin[k][4] = bf_lo(w.z); xin[k][5] = bf_hi(w.z); xin[k][6] = bf_lo(w.w); xin[k][7] = bf_hi(w.w); }
              if (item + G < 2 * NCH * 16) LRU_LOADX(item + G);
              float o[2][8];
#pragma unroll
              for (int e = 0; e < 8; ++e) { const float cb = PAR[512 + chg * 8 + e]; o[0][e] = cb; o[1][e] = cb; }
#pragma unroll
              for (int w = 0; w < 4; ++w)
#pragma unroll
                  for (int e = 0; e < 8; ++e) { const float cw = PAR[w * 128 + chg * 8 + e]; o[0][e] += cw * xin[w][e]; o[1][e] += cw * xin[w + 1][e]; }
#pragma unroll
              for (int e2 = 0; e2 < 2; ++e2) { u32x4 w; w.x = pk2(o[e2][0], o[e2][1]); w.y = pk2(o[e2][2], o[e2][3]); w.z = pk2(o[e2][4], o[e2][5]); w.w = pk2(o[e2][6], o[e2][7]);
                  *(LAS u32x4*)(XB + (2 * rg + e2) * 136 + chg * 8) = w; } }
            LDS_BAR();
            { f32x16 accR = {}, accI = {};
              const LAS bf16_t* xbp = XB + (tt * 32 + l31) * 136 + hi * 8;
#pragma unroll
              for (int kk = 0; kk < 8; ++kk) { const bf16x8 bxv = *(const LAS bf16x8*)(xbp + kk * 16);
                  accR = __builtin_amdgcn_mfma_f32_32x32x16_bf16(wrf[kk], bxv, accR, 0, 0, 0); accI = __builtin_amdgcn_mfma_f32_32x32x16_bf16(wif[kk], bxv, accI, 0, 0, 0); }
              const int t = tt * 32 + l31;
#pragma unroll
              for (int r = 0; r < 16; ++r) { const int j = jt * 32 + crow16(r, hi);
                  const float rr = sigmoidf_(accR[r] + PAR[640 + j]), ii = sigmoidf_(accI[r] + PAR[768 + j]);
                  const float a = __builtin_amdgcn_exp2f(-PAR[896 + j] * rr), mult = __builtin_amdgcn_sqrtf(fmaxf(1.f - a * a, 0.f));
                  const float xcv = __uint_as_float(((unsigned)XB[t * 136 + j]) << 16);
                  A_s[t * 129 + j] = a; B_s[t * 129 + j] = mult * ii * xcv; } }
            LDS_BAR();
            { const int j = tid & 127, seg = tid >> 7; float hl[16], pl[16]; float h = 0.f, pc = 1.f;
#pragma unroll
              for (int t = 0; t < 16; ++t) { const float a = A_s[(16 * seg + t) * 129 + j], bb = B_s[(16 * seg + t) * 129 + j]; h = a * h + bb; pc *= a; hl[t] = h; pl[t] = pc; }
              SEG[(seg * 128 + j) * 2] = pc; SEG[(seg * 128 + j) * 2 + 1] = h;
              LDS_BAR();
              float cp = 1.f, chh = 0.f;
              for (int sg = 0; sg < seg; ++sg) { const float ap = SEG[(sg * 128 + j) * 2], bh = SEG[(sg * 128 + j) * 2 + 1]; chh = ap * chh + bh; cp *= ap; }
              const size_t go = ((size_t)(b * TPAD + t0 + 16 * seg)) * 2048 + hd * 128 + j;
#pragma unroll
              for (int t = 0; t < 16; ++t) { const float hh = hl[t] + pl[t] * chh, pp = pl[t] * cp;
                  Hloc[go + (size_t)t * 2048] = (bf16_t)(pk2(hh, 0.f) & 0xffffu); Pc[go + (size_t)t * 2048] = (bf16_t)(pk2(pp, 0.f) & 0xffffu); }
              if (seg == 3) { Aagg[(b * 66 + c64) * 2048 + hd * 128 + j] = pl[15] * cp; Bagg[(b * 66 + c64) * 2048 + hd * 128 + j] = hl[15] + pl[15] * chh; } }
        }
        __syncthreads();
        }
#undef LRU_LOADX
#undef LDS_BAR
        }
        { att::Seam S;
          auto mk = [&](int L, int pass) { att::BlockRef r; const int vh = L >> 3, x = L & 7, qb = pass ? 15 - x : x, b = vh >> 5, h = (vh >> 2) & 7, c = (vh >> 1) & 1, vf = vh & 1;
              r.Q = (const att::bf16*)(Qb + ((size_t)(b * TPAD + NMETA + qb * 256)) * 2048 + h * 256 + c * 128);
              r.K = (const att::bf16*)(Kb + ((size_t)b * TPAD) * 2048 + h * 256 + c * 128);
              r.V = (const att::bf16*)(Vb + ((size_t)b * TPAD) * 2048 + h * 256 + vf * 128);
              r.O = (att::bf16*)(Opart + (size_t)c * MX * 2048 + ((size_t)(b * 4096 + qb * 256)) * 2048 + h * 256 + vf * 128);
              r.P0 = NMETA + qb * 256; return r; };
          int L = vcu;
          if (L < 512) {
              int pass = 0; att::BlockRef cur = mk(L, 0);
              att::prime(cur, (char*)lds, S);
              for (;;) {
                  const bool more_pass = (pass == 0), more_item = (L + G < 512), last = !more_pass && !more_item;
                  int Ln = L, passn = pass + 1; if (!more_pass) { passn = 0; Ln = more_item ? L + G : L; }
                  const att::BlockRef nxt = last ? cur : mk(Ln, passn);
                  att::block(cur, nxt, TPAD, (char*)lds, S);
                  if (last) break;
                  cur = nxt; pass = passn; L = Ln;
              }
          } }
    }
    SEAM(2);
    if (IN(3)) {
        const KP KA = kargs(); unsigned char* const ws = KA->ws;
        bf16_t* Cat = QKV;
        float lam;
        { const float a1 = KA->in[4][lane] * KA->in[5][lane] + KA->in[4][lane + 64] * KA->in[5][lane + 64], a2 = KA->in[6][lane] * KA->in[7][lane] + KA->in[6][lane + 64] * KA->in[7][lane + 64];
          lam = expf(wave_sum(a1)) - expf(wave_sum(a2)) + 0.2f; }
        for (int row = gw; row < MX; row += 4 * NGW) {
            u32x4 av[4][4], bv[4][4];
#pragma unroll
            for (int q = 0; q < 4; ++q) { const int rq = (row + q * NGW < MX) ? row + q * NGW : row;
#pragma unroll
                for (int j = 0; j < 4; ++j) { const int col = (lane + 64 * j) * 8;
                    av[q][j] = *(const u32x4*)(Opart + (size_t)rq * 2048 + col); bv[q][j] = *(const u32x4*)(Opart + (size_t)MX * 2048 + (size_t)rq * 2048 + col); } }
#pragma unroll
            for (int q = 0; q < 4; ++q) { const int rq = row + q * NGW; if (rq < MX) {
#pragma unroll
            for (int j = 0; j < 4; ++j) { const int col = (lane + 64 * j) * 8;
                const u32x4 a = av[q][j], bq = bv[q][j];
                float d[8]; d[0] = bf_lo(a.x) - lam * bf_lo(bq.x); d[1] = bf_hi(a.x) - lam * bf_hi(bq.x); d[2] = bf_lo(a.y) - lam * bf_lo(bq.y); d[3] = bf_hi(a.y) - lam * bf_hi(bq.y);
                d[4] = bf_lo(a.z) - lam * bf_lo(bq.z); d[5] = bf_hi(a.z) - lam * bf_hi(bq.z); d[6] = bf_lo(a.w) - lam * bf_lo(bq.w); d[7] = bf_hi(a.w) - lam * bf_hi(bq.w);
                float ss = 0.f;
#pragma unroll
                for (int e = 0; e < 8; ++e) ss += d[e] * d[e];
                ss += __shfl_xor(ss, 1); ss += __shfl_xor(ss, 2); ss += __shfl_xor(ss, 4); ss += __shfl_xor(ss, 8); ss += __shfl_xor(ss, 16);
                const float rs = rsqrtf(ss * (1.f / 256.f) + EPS) * 0.8f;
                const f32x4 g0 = *(const f32x4*)(KA->in[8] + (col & 255)), g1 = *(const f32x4*)(KA->in[8] + (col & 255) + 4);
                u32x4 w; w.x = pk2(d[0] * rs * g0[0], d[1] * rs * g0[1]); w.y = pk2(d[2] * rs * g0[2], d[3] * rs * g0[3]); w.z = pk2(d[4] * rs * g1[0], d[5] * rs * g1[1]); w.w = pk2(d[6] * rs * g1[2], d[7] * rs * g1[3]);
                *(u32x4*)(Cat + (size_t)rq * DM + col) = w; } } }
        }
        for (int it = vcu; it < 2 * 64 * 4; it += G) {
            const int cq = it & 3, bg = it >> 2, b = bg >> 6, g = b ? 63 - (bg & 63) : (bg & 63), chq = tid & 127, rgp = tid >> 7, ch = cq * 512 + chq * 4;
            const int pos0 = NMETA + 64 * g + 16 * rgp, c64 = pos0 >> 6;
            u32x2 pwv[16], hwv[16], gwv[16];
#pragma unroll
            for (int tt = 0; tt < 16; ++tt) { const size_t go = ((size_t)(b * TPAD + pos0 + tt)) * 2048 + ch; pwv[tt] = *(const u32x2*)(Pc + go); hwv[tt] = *(const u32x2*)(Hloc + go); gwv[tt] = *(const u32x2*)(GTb + go); }
            f32x4 carry = (f32x4){0.f, 0.f, 0.f, 0.f};
            { int cc = 0;
              for (; cc + 8 <= c64; cc += 8) { f32x4 A8[8], B8[8];
#pragma unroll
                  for (int q = 0; q < 8; ++q) { A8[q] = *(const f32x4*)(Aagg + (b * 66 + cc + q) * 2048 + ch); B8[q] = *(const f32x4*)(Bagg + (b * 66 + cc + q) * 2048 + ch); }
#pragma unroll
                  for (int q = 0; q < 8; ++q) carry = A8[q] * carry + B8[q]; }
              f32x4 A8[8], B8[8];
#pragma unroll
              for (int q = 0; q < 8; ++q) { const int cq_ = (cc + q < c64) ? cc + q : 0; A8[q] = *(const f32x4*)(Aagg + (b * 66 + cq_) * 2048 + ch); B8[q] = *(const f32x4*)(Bagg + (b * 66 + cq_) * 2048 + ch); }
#pragma unroll
              for (int q = 0; q < 8; ++q) if (cc + q < c64) carry = A8[q] * carry + B8[q]; }
#pragma unroll
            for (int tt = 0; tt < 16; ++tt) { const int pos = pos0 + tt;
                const u32x2 pw2 = pwv[tt], hw2 = hwv[tt], gw2 = gwv[tt];
                const f32x4 P4 = (f32x4){bf_lo(pw2.x), bf_hi(pw2.x), bf_lo(pw2.y), bf_hi(pw2.y)}, h4 = (f32x4){bf_lo(hw2.x), bf_hi(hw2.x), bf_lo(hw2.y), bf_hi(hw2.y)};
                const f32x4 hh = h4 + P4 * carry; float gv[4] = {bf_lo(gw2.x), bf_hi(gw2.x), bf_lo(gw2.y), bf_hi(gw2.y)}; float ov[4];
#pragma unroll
                for (int e = 0; e < 4; ++e) { const float gg = gv[e], z2 = 1.5957691216057308f * (gg + 0.044715f * gg * gg * gg); ov[e] = hh[e] * gg * sigmoidf_(z2); }
                u32x2 w; w.x = pk2(ov[0], ov[1]); w.y = pk2(ov[2], ov[3]);
                *(u32x2*)(Cat + ((size_t)(b * 4096 + pos - NMETA)) * DM + 2048 + ch) = w; }
        }
    }
    SEAM(3);
    if (IN(4)) {
        const KP KA = kargs(); unsigned char* const ws = KA->ws;
        pg8::Gemm g{QKV, Wout_t, MX, DM, DM}; pg8::StaticOrder S; S.init(MX, DM, G, bx);
        pg8::EpiBfSsq E{Mixed, ssq1, DM};
        pg8::gemm_phase<pg8::EpiBfSsq, pg8::StaticOrder, true, true>((LAS unsigned char*)lds, g, S, E);
    }
    SEAM(4);
    if (IN(5)) {
        const KP KA = kargs(); unsigned char* const ws = KA->ws;
        for (int row = gw; row < MX; row += 2 * NGW) {
            const int rB = (row + NGW < MX) ? row + NGW : row; const bool hasB = row + NGW < MX;
            const float sA = ssq1[(size_t)row * 64 + lane], sB = ssq1[(size_t)rB * 64 + lane];
            u32x2 xa[16], xb[16], ma[16], mb[16];
            { const u32x2* m4 = (const u32x2*)(Mixed + (size_t)row * DM) + lane; const u32x2* x4 = (const u32x2*)(Ubuf + (size_t)row * DM) + lane;
#pragma unroll
              for (int j = 0; j < 16; ++j) { xa[j] = x4[64 * j]; ma[j] = m4[64 * j]; } }
            { const u32x2* m4 = (const u32x2*)(Mixed + (size_t)rB * DM) + lane; const u32x2* x4 = (const u32x2*)(Ubuf + (size_t)rB * DM) + lane;
#pragma unroll
              for (int j = 0; j < 16; ++j) { xb[j] = x4[64 * j]; mb[j] = m4[64 * j]; } }
            const f32x4* gp = (const f32x4*)KA->in[17] + lane;
#define P5_ROW(R, XV, MV, SS) do { const float rs1 = rsqrtf(wave_sum(SS) * (1.f / DM) + EPS); float s2 = 0.f; u32x2* h8 = (u32x2*)(H1b + (size_t)(R) * DM) + lane; \
                _Pragma("unroll") for (int j = 0; j < 16; ++j) { const u32x2 mw = MV[j], xw = XV[j]; const f32x4 mv = (f32x4){bf_lo(mw.x), bf_hi(mw.x), bf_lo(mw.y), bf_hi(mw.y)}, xv = (f32x4){bf_lo(xw.x), bf_hi(xw.x), bf_lo(xw.y), bf_hi(xw.y)}; \
                    const f32x4 h = xv + mv * rs1 * gp[64 * j]; \
                    { u32x2 hw; hw.x = pk2(h[0], h[1]); hw.y = pk2(h[2], h[3]); h8[64 * j] = hw; } s2 += (h[0] * h[0] + h[1] * h[1]) + (h[2] * h[2] + h[3] * h[3]); } \
                const float rs2 = rsqrtf(wave_sum(s2) * (1.f / DM) + EPS); if (lane == 0) RS2[R] = rs2; } while (0)
            P5_ROW(row, xa, ma, sA);
            if (hasB) P5_ROW(rB, xb, mb, sB);
#undef P5_ROW
        }
    }
    SEAM(5);
    if (IN(6)) {
        const KP KA = kargs(); unsigned char* const ws = KA->ws;
        pg8::Gemm g{H1b, Wgu_t, MX, NGU, DM}; pg8::StaticOrder S; S.init(MX, NGU, G, bx);
        pg8::EpiGU E{QKV, DFF, RS2};
        pg8::gemm_phase<pg8::EpiGU, pg8::StaticOrder, true, true>((LAS unsigned char*)lds, g, S, E);
        { const int rem = S.nwg % G, nshort = rem ? G - rem : G, sidx = rem ? bx - rem : bx;
          if (sidx >= 0) {
              __syncthreads();
              const KP KB = kargs(); bf16_t* const wdn = (bf16_t*)(KB->ws + WS_WDN);
              LAS float* scr = (LAS float*)((LAS unsigned char*)lds + wave * 16640);
              tr_run<DFF, DM>(KB->in[21], KB->in[21], 172 * 64, wdn, 0, 0, scr, WDN_EARLY + sidx * 8 + wave, 172 * 64, nshort * 8, lane);
          } }
    }
    SEAM(6);
    if (IN(7)) {
        const KP KA = kargs(); unsigned char* const ws = KA->ws;
        pg8::Gemm g{QKV, Wdn_t, MX, DM, DFF}; pg8::StaticOrder S; S.init(MX, DM, G, bx);
        pg8::EpiBfSsq E{Mixed, ssq2, DM};
        pg8::gemm_phase<pg8::EpiBfSsq, pg8::StaticOrder, true, true>((LAS unsigned char*)lds, g, S, E);
    }
    SEAM(7);
    if (IN(8)) {
        const KP KA = kargs(); unsigned char* const ws = KA->ws;
        const f32x4* gp = (const f32x4*)KA->in[22] + lane;
        for (int row = gw; row < MX; row += 2 * NGW) {
            const int rB = (row + NGW < MX) ? row + NGW : row; const bool hasB = row + NGW < MX;
            const float sA = ssq2[(size_t)row * 64 + lane], sB = ssq2[(size_t)rB * 64 + lane];
            u32x2 fa[16], ha[16], fb[16], hb[16];
            { const u32x2* f4 = (const u32x2*)(Mixed + (size_t)row * DM) + lane; const u32x2* h8 = (const u32x2*)(H1b + (size_t)row * DM) + lane;
#pragma unroll
              for (int j = 0; j < 16; ++j) { fa[j] = f4[64 * j]; ha[j] = h8[64 * j]; } }
            { const u32x2* f4 = (const u32x2*)(Mixed + (size_t)rB * DM) + lane; const u32x2* h8 = (const u32x2*)(H1b + (size_t)rB * DM) + lane;
#pragma unroll
              for (int j = 0; j < 16; ++j) { fb[j] = f4[64 * j]; hb[j] = h8[64 * j]; } }
#define P8_ROW(R, FV, HV, SS) do { const float rs = rsqrtf(wave_sum(SS) * (1.f / DM) + EPS); f32x4* o4 = (f32x4*)(KA->out + (size_t)(R) * DM) + lane; \
                _Pragma("unroll") for (int j = 0; j < 16; ++j) { const u32x2 fw = FV[j], hw = HV[j]; const f32x4 fv = (f32x4){bf_lo(fw.x), bf_hi(fw.x), bf_lo(fw.y), bf_hi(fw.y)}, hv = (f32x4){bf_lo(hw.x), bf_hi(hw.x), bf_lo(hw.y), bf_hi(hw.y)}; \
                    __builtin_nontemporal_store(hv + fv * rs * gp[64 * j], o4 + 64 * j); } } while (0)
            P8_ROW(row, fa, ha, sA);
            if (hasB) P8_ROW(rB, fb, hb, sB);
#undef P8_ROW
        }
    }
#undef IN
#undef SEAM
}

extern "C" void kernel_launch(void* const* d_in, const int* in_sizes, int n_in, void* d_out, int out_size, void* d_ws, size_t ws_size, hipStream_t stream) {
    static int grid = 0;
    if (grid == 0) {
        if (n_in != 23 || ws_size < WS_END) { fprintf(stderr, "kernel_launch: unexpected n_in %d or ws_size %zu (need %zu)\n", n_in, ws_size, (size_t)WS_END); }
        int dev = 0, cus = 0, per_cu = 0;
        (void)hipGetDevice(&dev); (void)hipDeviceGetAttribute(&cus, hipDeviceAttributeMultiprocessorCount, dev);
        if (hipFuncSetAttribute((const void*)fwd_mega, hipFuncAttributeMaxDynamicSharedMemorySize, LDS_BYTES) != hipSuccess) fprintf(stderr, "kernel_launch: hipFuncSetAttribute failed\n");
        if (hipOccupancyMaxActiveBlocksPerMultiprocessor(&per_cu, (const void*)fwd_mega, 512, LDS_BYTES) != hipSuccess || per_cu < 1) { fprintf(stderr, "kernel_launch: occupancy query says %d\n", per_cu); per_cu = 1; }
        (void)hipGetLastError();
        if (cus <= 0) cus = 256;
        grid = cus;
    }
    Params p{};
    for (int i = 0; i < 23; ++i) p.in[i] = (const float*)d_in[i];
    p.out = (float*)d_out; p.ws = (unsigned char*)d_ws;
    if (hipMemsetAsync((char*)d_ws + 4096, 0, XCD_BAR_WORDS * sizeof(unsigned), stream) != hipSuccess) fprintf(stderr, "kernel_launch: memset of the barrier words failed\n");
    const int nl = (PROBE_REP >= 0) ? 2 : MK_N_LAUNCHES;
    for (int li = 0; li < nl; ++li) {
        if (PROBE_REP >= 0) { p.ph_lo = li ? PROBE_REP : 0; p.ph_hi = li ? NPHASE : PROBE_REP + 1; }
        else if (MK_N_LAUNCHES == 1) { p.ph_lo = 0; p.ph_hi = NPHASE; } else { p.ph_lo = li; p.ph_hi = li + 1; }
        void* args[] = {&p};
        hipError_t e = hipLaunchCooperativeKernel((const void*)fwd_mega, dim3(grid), dim3(512), args, LDS_BYTES, stream);
        if (e != hipSuccess) { fprintf(stderr, "kernel_launch: cooperative launch %d failed: %s (grid %d)\n", li, hipGetErrorString(e), grid); break; }
    }
}
```

```cpp
#include <hip/hip_runtime.h>
#include <hip/hip_bf16.h>
#include <hip/hip_cooperative_groups.h>
#include <cstdio>
#include <cstdint>
namespace cg = cooperative_groups;
namespace pg8 {
#define PG8_LAS __attribute__((address_space(3)))
typedef unsigned short bf16_t;
typedef short bf16x8 __attribute__((ext_vector_type(8)));
typedef float f32x4 __attribute__((ext_vector_type(4)));
typedef unsigned u32x4 __attribute__((ext_vector_type(4)));
constexpr int BM = 256, BK = 64, HALF = 128, HTB = HALF * BK * 2  , STAGE_BYTES = 8 * HTB, NXCD = 8, WGM = 8;

__host__ __device__ __forceinline__ int lds_byte(int r, int c) { const int st = (r >> 4) * 2 + (c >> 5), rr = r & 15, cc = c & 31, ob = rr * 64 + cc * 2; return st * 1024 + (ob ^ (((ob >> 9) & 1) << 5)); }
__host__ __device__ __forceinline__ void stage_rc(int b, int& R, int& C) { const int st = b / 1024, sb = b % 1024, swz = sb ^ (((sb >> 9) & 1) << 5); R = (st >> 1) * 16 + swz / 64; C = (st & 1) * 32 + (swz % 64) / 2; }
__host__ __device__ __forceinline__ int perm32(int rho) { const int n = rho >> 4, i = rho & 15; return 8 * (i >> 2) + 4 * n + (i & 3); }

struct Unit { int pm, pn; };
struct Gemm { const bf16_t* A; const bf16_t* Bt; int M, N, K; };

struct StaticOrder {
    int nM, nN, nwg, G, c;
    __host__ __device__ void init(int M, int N, int G_, int c_) { nM = M / BM; nN = N / BM; nwg = nM * nN; G = G_; c = c_; }
    __host__ __device__ bool next(int i, Unit& u) const {
        const long L = (long)i * G + c; if (L >= nwg) return false;
        int wgid = (int)L; { const int q = nwg / NXCD, r = nwg % NXCD, xcd = wgid % NXCD, off = wgid / NXCD; wgid = (xcd < r ? xcd * (q + 1) : r * (q + 1) + (xcd - r) * q) + off; }
        const int nig = WGM * nN, gid = wgid / nig, fm = gid * WGM, gsz = (nM - fm) < WGM ? (nM - fm) : WGM;
        u.pm = fm + ((wgid % nig) % gsz); u.pn = (wgid % nig) / gsz; return true;
    }
    __device__ __forceinline__ void a_ready(const Unit&) const {}
    __device__ __forceinline__ void done(const Unit&) const {}
};

__device__ __forceinline__ unsigned cvt_pk_bf16(float lo, float hi) { unsigned r; asm volatile("v_cvt_pk_bf16_f32 %0, %1, %2" : "=v"(r) : "v"(lo), "v"(hi)); return r; }
__device__ __forceinline__ u32x4 pack8f(const f32x4 a, const f32x4 b) { u32x4 w; w.x = cvt_pk_bf16(a[0], a[1]); w.y = cvt_pk_bf16(a[2], a[3]); w.z = cvt_pk_bf16(b[0], b[1]); w.w = cvt_pk_bf16(b[2], b[3]); return w; }
constexpr int TPAD = 4224, NMETA_ = 16, QKV_ROWS = 2 * TPAD;
struct EpiIn {
    static constexpr bool PERM = true, AFTER_DRAIN = false;
    bf16_t* base; const float* cosT; const float* sinT; const float* rs1;
    __device__ __forceinline__ void operator()(const f32x4 (&acc)[2][2][4][2], const Unit& u, int wr, int wc, int fr, int fq) const {
        const int sect = u.pn >> 3, hd = u.pn & 7;
        bf16_t* buf = base + (size_t)sect * ((size_t)QKV_ROWS * 2048);
        const int j0 = wc * 32 + 8 * fq;
#pragma unroll
        for (int ai = 0; ai < 2; ++ai)
#pragma unroll
            for (int m = 0; m < 4; ++m) {
                const int grow = u.pm * BM + ai * HALF + wr * 64 + m * 16 + fr;
                const int pos = NMETA_ + (grow & 4095), srow = (grow >> 12) * TPAD + pos;
                const float rr = rs1[grow];
                const f32x4 a00 = acc[ai][0][m][0] * rr, a01 = acc[ai][0][m][1] * rr, a10 = acc[ai][1][m][0] * rr, a11 = acc[ai][1][m][1] * rr;
                if (sect < 2) {
                    const int comp = j0 >> 6, i0 = j0 & 63;
                    const f32x4 c0 = *(const f32x4*)(cosT + pos * 64 + i0), c1 = *(const f32x4*)(cosT + pos * 64 + i0 + 4);
                    const f32x4 s0 = *(const f32x4*)(sinT + pos * 64 + i0), s1 = *(const f32x4*)(sinT + pos * 64 + i0 + 4);
                    const f32x4 x1a = a00, x1b = a01, x2a = a10, x2b = a11;
                    const f32x4 o1a = x1a * c0 - x2a * s0, o1b = x1b * c1 - x2b * s1, o2a = x2a * c0 + x1a * s0, o2b = x2b * c1 + x1b * s1;
                    const u32x4 w1 = pack8f(o1a, o1b), w2 = pack8f(o2a, o2b);
                    bf16_t* p = buf + (size_t)srow * 2048 + hd * 256 + comp * 128 + i0;
                    *(u32x4*)p = w1; *(u32x4*)(p + 64) = w2;
                } else {
#pragma unroll
                    for (int bj = 0; bj < 2; ++bj) { const u32x4 w = bj ? pack8f(a10, a11) : pack8f(a00, a01);
                        bf16_t* p = buf + (size_t)srow * 2048 + hd * 256 + bj * HALF + j0;
                        *(u32x4*)p = w; }
                }
            }
    }
};
struct EpiBfSsq {
    static constexpr bool PERM = true, AFTER_DRAIN = false;
    bf16_t* O; float* ssq; int ldc;
    __device__ __forceinline__ void operator()(const f32x4 (&acc)[2][2][4][2], const Unit& u, int wr, int wc, int fr, int fq) const {
        const int col0 = u.pn * BM + wc * 32 + 8 * fq;
#pragma unroll
        for (int ai = 0; ai < 2; ++ai)
#pragma unroll
            for (int m = 0; m < 4; ++m) {
                const int row = u.pm * BM + ai * HALF + wr * 64 + m * 16 + fr; float s = 0.f;
                bf16_t* rowp = O + (size_t)row * ldc + col0;
#pragma unroll
                for (int bj = 0; bj < 2; ++bj) { const f32x4 v0 = acc[ai][bj][m][0], v1 = acc[ai][bj][m][1];
                    *(u32x4*)(rowp + bj * HALF) = pack8f(v0, v1);
                    s += (v0[0] * v0[0] + v0[1] * v0[1]) + (v0[2] * v0[2] + v0[3] * v0[3]) + (v1[0] * v1[0] + v1[1] * v1[1]) + (v1[2] * v1[2] + v1[3] * v1[3]); }
                s += __shfl_xor(s, 16); s += __shfl_xor(s, 32);
                if (fq == 0) ssq[(size_t)row * 64 + u.pn * 4 + wc] = s;
            }
    }
};
struct EpiGU {
    static constexpr bool PERM = true, AFTER_DRAIN = false;
    bf16_t* O; int ldc; const float* rs;
    __device__ __forceinline__ void operator()(const f32x4 (&acc)[2][2][4][2], const Unit& u, int wr, int wc, int fr, int fq) const {
        const int col0 = u.pn * HALF + wc * 32 + 8 * fq;
#pragma unroll
        for (int ai = 0; ai < 2; ++ai)
#pragma unroll
            for (int m = 0; m < 4; ++m) {
                const int row = u.pm * BM + ai * HALF + wr * 64 + m * 16 + fr; const float rr = rs[row];
                f32x4 r0, r1;
#pragma unroll
                for (int e = 0; e < 4; ++e) {
                    const float g0 = acc[ai][0][m][0][e] * rr, g1 = acc[ai][0][m][1][e] * rr;
                    r0[e] = g0 * __builtin_amdgcn_rcpf(1.f + __builtin_amdgcn_exp2f(-1.4426950408889634f * g0)) * (acc[ai][1][m][0][e] * rr);
                    r1[e] = g1 * __builtin_amdgcn_rcpf(1.f + __builtin_amdgcn_exp2f(-1.4426950408889634f * g1)) * (acc[ai][1][m][1][e] * rr);
                }
                *(u32x4*)(O + (size_t)row * ldc + col0) = pack8f(r0, r1);
            }
    }
};

template <class Epi, class Sched, bool ALIGN_EPI = false, bool SP2 = false>
__device__ __forceinline__ void gemm_phase(PG8_LAS unsigned char* lds, const Gemm g, const Sched& S, const Epi& E) {
    const int tid = threadIdx.x, wid = __builtin_amdgcn_readfirstlane(tid >> 6), lane = tid & 63, wr = wid >> 2, wc = wid & 3, fr = lane & 15, fq = lane >> 4;
    const int K = g.K, nt = K / BK;
    unsigned voffA[2], voffB[2];
#pragma unroll
    for (int i = 0; i < 2; ++i) { int R, C; stage_rc(tid * 16 + i * 8192, R, C); const int Rb = Epi::PERM ? ((R & ~31) + perm32(R & 31)) : R;
        voffA[i] = (unsigned)(R * K + C) * 2u; voffB[i] = (unsigned)(Rb * K + C) * 2u; }
    const size_t kstep = (size_t)(BK * 2);
    const size_t hstep = (size_t)HALF * K * 2;
    const size_t tstep = 2 * hstep;
    const unsigned ldsw = (unsigned)wid * 1024u;
    const int aoff = lds_byte(wr * 64 + fr, fq * 8), boff = lds_byte(wc * 32 + fr, fq * 8);
#define PG8_SA(b, h) (((b) * 2 + (h)) * HTB)
#define PG8_SB(b, h) ((4 + (b) * 2 + (h)) * HTB)
#define PG8_STAGE(bufoff, gbase, voff) do { _Pragma("unroll") for (int _i = 0; _i < 2; ++_i) \
        __builtin_amdgcn_global_load_lds((const unsigned*)((const char*)(gbase) + (voff)[_i]), (PG8_LAS unsigned*)(lds + (bufoff) + ldsw + _i * 8192), 16, 0, 0); } while (0)
#define PG8_LDA(dst, b, h) do { _Pragma("unroll") for (int m = 0; m < 4; ++m) _Pragma("unroll") for (int k = 0; k < 2; ++k) dst[m][k] = *(const PG8_LAS bf16x8*)(lds + PG8_SA(b, h) + aoff + m * 2048 + k * 1024); } while (0)
#define PG8_LDB(dst, b, h) do { _Pragma("unroll") for (int n = 0; n < 2; ++n) _Pragma("unroll") for (int k = 0; k < 2; ++k) dst[n][k] = *(const PG8_LAS bf16x8*)(lds + PG8_SB(b, h) + boff + n * 2048 + k * 1024); } while (0)
#define PG8_MMA(ai, bj, At, Bt) do { __builtin_amdgcn_s_setprio(1); _Pragma("unroll") for (int m = 0; m < 4; ++m) _Pragma("unroll") for (int n = 0; n < 2; ++n) _Pragma("unroll") for (int k = 0; k < 2; ++k) \
        acc[ai][bj][m][n] = __builtin_amdgcn_mfma_f32_16x16x32_bf16(Bt[n][k], At[m][k], acc[ai][bj][m][n], 0, 0, 0); __builtin_amdgcn_s_setprio(0); } while (0)
#define PG8_WAIT_V(n) asm volatile("s_waitcnt vmcnt(" #n ")" ::: "memory")
#define PG8_WAIT_L(n) asm volatile("s_waitcnt lgkmcnt(" #n ")" ::: "memory")
#define PG8_BAR __builtin_amdgcn_s_barrier()
#define PG8_SCHED __builtin_amdgcn_sched_barrier(0)
    Unit cur, nxt; int ui = 0;
    if (!S.next(0, cur)) return;
    f32x4 acc[2][2][4][2];
#pragma unroll
    for (int a = 0; a < 2; ++a)
#pragma unroll
        for (int b = 0; b < 2; ++b)
#pragma unroll
            for (int m = 0; m < 4; ++m)
#pragma unroll
                for (int n = 0; n < 2; ++n) acc[a][b][m][n] = (f32x4){0.f, 0.f, 0.f, 0.f};
    bf16x8 At[4][2], B0[2][2], B1[2][2];
    const char* cA = (const char*)g.A + (size_t)cur.pm * tstep; const char* cB = (const char*)g.Bt + (size_t)cur.pn * tstep;
    S.a_ready(cur);
    if constexpr (SP2) {
        PG8_STAGE(PG8_SB(0, 0), cB, voffB); PG8_STAGE(PG8_SB(0, 1), cB + hstep, voffB); PG8_STAGE(PG8_SA(0, 0), cA, voffA); PG8_STAGE(PG8_SA(0, 1), cA + hstep, voffA);
        if (wr == 1) PG8_BAR;
        PG8_WAIT_V(2); PG8_BAR;
        PG8_STAGE(PG8_SB(1, 0), cB + kstep, voffB); PG8_STAGE(PG8_SA(1, 0), cA + kstep, voffA); PG8_STAGE(PG8_SB(1, 1), cB + hstep + kstep, voffB);
        PG8_WAIT_V(6); PG8_BAR;
    } else {
        PG8_STAGE(PG8_SB(0, 0), cB, voffB); PG8_STAGE(PG8_SA(0, 0), cA, voffA); PG8_STAGE(PG8_SB(0, 1), cB + hstep, voffB); PG8_STAGE(PG8_SA(0, 1), cA + hstep, voffA);
        if (wr == 1) PG8_BAR;
        PG8_WAIT_V(4); PG8_BAR;
        PG8_STAGE(PG8_SB(1, 0), cB + kstep, voffB); PG8_STAGE(PG8_SA(1, 0), cA + kstep, voffA); PG8_STAGE(PG8_SB(1, 1), cB + hstep + kstep, voffB);
        PG8_WAIT_V(6); PG8_BAR;
    }
    for (;;) {
        const bool has_next = S.next(ui + 1, nxt);
        const char* nA = has_next ? (const char*)g.A + (size_t)nxt.pm * tstep : cA; const char* nB = has_next ? (const char*)g.Bt + (size_t)nxt.pn * tstep : cB;
        for (int t = 0; t < nt; t += 2) {
            const bool last = (t == nt - 2);
            const char* a1 = cA + (size_t)(t + 1) * kstep;
            const char* a2 = last ? nA : cA + (size_t)(t + 2) * kstep; const char* b2 = last ? nB : cB + (size_t)(t + 2) * kstep;
            const char* a3 = a2 + kstep; const char* b3 = b2 + kstep;
            if (last && has_next) S.a_ready(nxt);
            if constexpr (SP2) {
            PG8_LDB(B0, 0, 0); PG8_LDB(B1, 0, 1); PG8_SCHED; PG8_LDA(At, 0, 0); PG8_STAGE(PG8_SA(1, 1), a1 + hstep, voffA);
            PG8_WAIT_V(8); PG8_WAIT_L(0); PG8_BAR; PG8_MMA(0, 0, At, B0); PG8_MMA(0, 1, At, B1); PG8_BAR; PG8_SCHED;
            PG8_LDA(At, 0, 1); PG8_STAGE(PG8_SB(0, 0), b2, voffB); PG8_STAGE(PG8_SB(0, 1), b2 + hstep, voffB); PG8_STAGE(PG8_SA(0, 0), a2, voffA);
            PG8_WAIT_V(8); PG8_WAIT_L(0); PG8_BAR; PG8_MMA(1, 0, At, B0); PG8_MMA(1, 1, At, B1); PG8_BAR; PG8_SCHED;
            PG8_LDB(B0, 1, 0); PG8_LDB(B1, 1, 1); PG8_SCHED; PG8_LDA(At, 1, 0); PG8_STAGE(PG8_SA(0, 1), a2 + hstep, voffA);
            PG8_WAIT_V(8); PG8_WAIT_L(0); PG8_BAR; PG8_MMA(0, 0, At, B0); PG8_MMA(0, 1, At, B1); PG8_BAR; PG8_SCHED;
            PG8_LDA(At, 1, 1); PG8_STAGE(PG8_SB(1, 0), b3, voffB); PG8_STAGE(PG8_SB(1, 1), b3 + hstep, voffB); PG8_STAGE(PG8_SA(1, 0), a3, voffA);
            PG8_WAIT_V(8); PG8_WAIT_L(0); PG8_BAR; PG8_MMA(1, 0, At, B0); PG8_MMA(1, 1, At, B1); PG8_BAR; PG8_SCHED;
            } else {
            PG8_LDB(B0, 0, 0); PG8_SCHED; PG8_LDA(At, 0, 0); PG8_STAGE(PG8_SA(1, 1), a1 + hstep, voffA);
            PG8_WAIT_L(8); PG8_BAR; PG8_WAIT_L(0); PG8_MMA(0, 0, At, B0); PG8_BAR; PG8_SCHED;
            PG8_LDB(B1, 0, 1); PG8_STAGE(PG8_SB(0, 0), b2, voffB);
            PG8_BAR; PG8_WAIT_L(0); PG8_MMA(0, 1, At, B1); PG8_BAR;
            PG8_LDA(At, 0, 1); PG8_STAGE(PG8_SA(0, 0), a2, voffA);
            PG8_BAR; PG8_WAIT_L(0); PG8_MMA(1, 0, At, B0); PG8_BAR; PG8_SCHED;
            PG8_STAGE(PG8_SB(0, 1), b2 + hstep, voffB);
            PG8_WAIT_V(6); PG8_BAR; PG8_MMA(1, 1, At, B1); PG8_BAR;
            PG8_LDB(B0, 1, 0); PG8_SCHED; PG8_LDA(At, 1, 0); PG8_STAGE(PG8_SA(0, 1), a2 + hstep, voffA);
            PG8_WAIT_L(8); PG8_BAR; PG8_WAIT_L(0); PG8_MMA(0, 0, At, B0); PG8_BAR; PG8_SCHED;
            PG8_LDB(B1, 1, 1); PG8_STAGE(PG8_SB(1, 0), b3, voffB);
            PG8_BAR; PG8_WAIT_L(0); PG8_MMA(0, 1, At, B1); PG8_BAR;
            PG8_LDA(At, 1, 1); PG8_STAGE(PG8_SA(1, 0), a3, voffA);
            PG8_BAR; PG8_WAIT_L(0); PG8_MMA(1, 0, At, B0); PG8_BAR; PG8_SCHED;
            PG8_STAGE(PG8_SB(1, 1), b3 + hstep, voffB);
            PG8_WAIT_V(6); PG8_BAR; PG8_MMA(1, 1, At, B1); PG8_BAR;
            }
        }
        if constexpr (ALIGN_EPI) { if (wr == 0) PG8_BAR; }
        if constexpr (!Epi::AFTER_DRAIN) { E(acc, cur, wr, wc, fr, fq); S.done(cur); }
        if (!has_next) break;
#pragma unroll
        for (int a = 0; a < 2; ++a)
#pragma unroll
            for (int b = 0; b < 2; ++b)
#pragma unroll
                for (int m = 0; m < 4; ++m)
#pragma unroll
                    for (int n = 0; n < 2; ++n) acc[a][b][m][n] = (f32x4){0.f, 0.f, 0.f, 0.f};
        cur = nxt; cA = nA; cB = nB; ++ui;
        if constexpr (ALIGN_EPI) { if (wr == 1) PG8_BAR; }
    }
    PG8_WAIT_V(0);
    if constexpr (!ALIGN_EPI) { if (wr == 0) PG8_BAR; }
    PG8_BAR;
    if constexpr (Epi::AFTER_DRAIN) { E.fused(acc, cur, wr, wc, fr, fq, lds, wid, lane); S.done(cur); }
#undef PG8_SA
#undef PG8_SB
#undef PG8_STAGE
#undef PG8_LDA
#undef PG8_LDB
#undef PG8_MMA
#undef PG8_WAIT_V
#undef PG8_WAIT_L
#undef PG8_BAR
#undef PG8_SCHED
}
}
namespace att {
constexpr float SCALE = 0.08838834764831845f, THR = 8.f;
constexpr int NW = 8, QBLK = 32, KVBLK = 64, QB = NW * QBLK, D = 128, PITCH = 2048;
constexpr int SHM_V = KVBLK * D * 2, SHM_K = KVBLK * D * 2;
constexpr int LDS_BYTES = 2 * SHM_V + 2 * SHM_K + NW * 64 * 4;
using bf16 = __hip_bfloat16;
typedef short bf16x8 __attribute__((ext_vector_type(8)));
typedef short s16x4 __attribute__((ext_vector_type(4)));
typedef float f32x16 __attribute__((ext_vector_type(16)));
typedef float f32x4 __attribute__((ext_vector_type(4)));
typedef unsigned u32x4 __attribute__((ext_vector_type(4)));
template <class A, class Bt> struct same_t { static constexpr bool v = false; };
template <class A> struct same_t<A, A> { static constexpr bool v = true; };

#define KSWZ(row, colB) ((row) * 256 + ((colB) ^ (((row) & 7) << 4)))
#define SBAR() __builtin_amdgcn_sched_barrier(0)
__device__ __forceinline__ int v_st(int k, int c) { const int kk = (k & ~0xC) | ((k & 4) << 1) | ((k & 8) >> 1); return ((kk >> 3) * 4 + (c >> 5)) * 512 + ((kk & 7) * 32 + (c & 31)) * 2; }
__device__ __forceinline__ int v_rd_base(int lane) { return ((lane & 3) << 3) | (((lane >> 2) & 3) << 6) | (((lane >> 4) & 1) << 5) | (((lane >> 5) & 1) << 8); }
constexpr int v_rd_off(int d0, int ks, int half) { return d0 * 512 + ks * 4096 + half * 2048; }
__device__ __forceinline__ int crow(int r, int hi) { return (r & 3) + 8 * (r >> 2) + 4 * hi; }
__device__ __forceinline__ unsigned cvtpk(float lo, float hi) {
    unsigned r; asm volatile("v_cvt_pk_bf16_f32 %0, %1, %2" : "=v"(r) : "v"(lo), "v"(hi)); return r;
}
__device__ __forceinline__ bf16x8 pack8(f32x4 a, f32x4 b) {
    u32x4 w = {cvtpk(a[0], a[1]), cvtpk(a[2], a[3]), cvtpk(b[0], b[1]), cvtpk(b[2], b[3])};
    return *reinterpret_cast<bf16x8*>(&w);
}
template <class T> __device__ __forceinline__ bf16x8 load8(const T* p) {
    if constexpr (same_t<T, float>::v) { return pack8(*(const f32x4*)p, *(const f32x4*)(p + 4)); }
    else { return *reinterpret_cast<const bf16x8*>(p); }
}
__device__ __forceinline__ void mask_tile(f32x16& p0, f32x16& p1, int dq, unsigned W) {
    const float NEG = -__builtin_inff();
#pragma unroll
    for (int r = 0; r < 16; ++r) {
        const int c = (r & 3) + 8 * (r >> 2);
        if ((unsigned)(dq - c) >= W) p0[r] = NEG;
        if ((unsigned)(dq - c - 32) >= W) p1[r] = NEG;
    }
}
__device__ __forceinline__ void partialSM(f32x16& p0, f32x16& p1, float& m_reg, float& mn, float& alpha) {
    float pmax;
    {
#define MX3_(a, b, c) __builtin_fmaxf(__builtin_fmaxf((a), (b)), (c))
      float a = MX3_(p0[0], p0[1], p1[0]), b = MX3_(p0[2], p0[3], p1[1]); a = MX3_(a, p1[2], p1[3]);
#pragma unroll
      for (int r = 4; r < 16; r += 4) { a = MX3_(a, p0[r], p0[r + 1]); b = MX3_(b, p0[r + 2], p0[r + 3]); a = MX3_(a, p1[r], p1[r + 1]); b = MX3_(b, p1[r + 2], p1[r + 3]); }
      pmax = __builtin_fmaxf(a, b);
#undef MX3_
    }
    { auto rr = __builtin_amdgcn_permlane32_swap(__float_as_uint(pmax), __float_as_uint(pmax), false, false);
      pmax = fmaxf(__uint_as_float(rr[0]), __uint_as_float(rr[1])); }
    constexpr float C2 = 1.4426950408889634f * SCALE;
    if (__builtin_expect(__all((pmax - m_reg) * SCALE <= THR), 1)) { mn = m_reg; alpha = 1.f; }
    else { mn = fmaxf(m_reg, pmax); alpha = __builtin_amdgcn_exp2f((m_reg - mn) * C2); m_reg = mn; }
    const float mnL = -mn * C2;
    for (int r = 0; r < 16; ++r) p0[r] = fmaf(p0[r], C2, mnL); for (int r = 0; r < 16; ++r) p1[r] = fmaf(p1[r], C2, mnL);
    for (int r = 0; r < 16; ++r) p0[r] = __builtin_amdgcn_exp2f(p0[r]);
}
__device__ __forceinline__ void finishSM(f32x16& p0, f32x16& p1, float alpha, float& l_reg, bf16x8& pa0, bf16x8& pa1, bf16x8& pa2, bf16x8& pa3) {
    for (int r = 0; r < 16; ++r) p1[r] = __builtin_amdgcn_exp2f(p1[r]);
    float ps;
    {
      float s0 = p0[0] + p1[0], s1 = p0[1] + p1[1], s2 = p0[2] + p1[2], s3 = p0[3] + p1[3];
#pragma unroll
      for (int r = 4; r < 16; r += 4) { s0 += p0[r]; s1 += p0[r + 1]; s2 += p0[r + 2]; s3 += p0[r + 3]; s0 += p1[r]; s1 += p1[r + 1]; s2 += p1[r + 2]; s3 += p1[r + 3]; }
      ps = (s0 + s1) + (s2 + s3); }
    { auto rr = __builtin_amdgcn_permlane32_swap(__float_as_uint(ps), __float_as_uint(ps), false, false);
      ps = __uint_as_float(rr[0]) + __uint_as_float(rr[1]); }
    l_reg = l_reg * alpha + ps;
#define PK4(P, B_, OUT) do { unsigned a0 = cvtpk(P[B_+0], P[B_+1]), a1 = cvtpk(P[B_+2], P[B_+3]);                          \
        unsigned b0 = cvtpk(P[B_+4], P[B_+5]), b1 = cvtpk(P[B_+6], P[B_+7]);                                             \
        auto r0 = __builtin_amdgcn_permlane32_swap(a0, b0, false, false); auto r1 = __builtin_amdgcn_permlane32_swap(a1, b1, false, false); \
        u32x4 w = {r0[0], r1[0], r0[1], r1[1]}; OUT = *reinterpret_cast<bf16x8*>(&w); } while (0)
    PK4(p0, 0, pa0); PK4(p0, 8, pa1); PK4(p1, 0, pa2); PK4(p1, 8, pa3);
#undef PK4
}
template <int KB, bool SK>
__device__ __forceinline__ void qkt(f32x16& p0, f32x16& p1, const char* K_lds, int r32, int hi, const bf16x8* qr, bool act) {
    if (SK && !act) { const float NEG = -__builtin_inff();
#pragma unroll
        for (int r = 0; r < 16; ++r) { p0[r] = NEG; p1[r] = NEG; } return; }
    p0 = f32x16{}; p1 = f32x16{};
    const char* kb[4];
#pragma unroll
    for (int dd = 0; dd < 4; ++dd) kb[dd] = K_lds + KB * SHM_K + KSWZ(r32, (dd * 16 + hi * 8) * 2);
#pragma unroll
    for (int d0 = 0; d0 < 8; ++d0) { const char* a = kb[d0 & 3] + (d0 >> 2) * 128;
        bf16x8 b0 = *reinterpret_cast<const bf16x8*>(a);
        bf16x8 b1 = *reinterpret_cast<const bf16x8*>(a + 32 * 256);
        p0 = __builtin_amdgcn_mfma_f32_32x32x16_bf16(b0, qr[d0], p0, 0, 0, 0);
        p1 = __builtin_amdgcn_mfma_f32_32x32x16_bf16(b1, qr[d0], p1, 0, 0, 0); }
}
template <int VB, bool SK>
__device__ __forceinline__ void pv_tile(f32x16* o, int vb0, bf16x8 pa0, bf16x8 pa1, bf16x8 pa2, bf16x8 pa3, bool act) {
    if (SK && !act) return;
#define TRRD(dst, off) asm volatile("ds_read_b64_tr_b16 %0, %1 offset:%2" : "=&v"(dst) : "v"(vb0), "i"(off) : "memory")
#define PV_D0(d0) do { s16x4 l0, l1, l2, l3, h0, h1, h2, h3; constexpr int b_ = VB * SHM_V + v_rd_off(d0, 0, 0);     \
        TRRD(l0, b_); TRRD(h0, b_ + 2048); TRRD(l1, b_ + 4096); TRRD(h1, b_ + 6144); TRRD(l2, b_ + 8192); TRRD(h2, b_ + 10240); TRRD(l3, b_ + 12288); TRRD(h3, b_ + 14336); \
        asm volatile("s_waitcnt lgkmcnt(0)" ::: "memory"); SBAR();                 \
        o[d0] = __builtin_amdgcn_mfma_f32_32x32x16_bf16(pa0, (bf16x8){l0[0], l0[1], l0[2], l0[3], h0[0], h0[1], h0[2], h0[3]}, o[d0], 0, 0, 0);   \
        o[d0] = __builtin_amdgcn_mfma_f32_32x32x16_bf16(pa1, (bf16x8){l1[0], l1[1], l1[2], l1[3], h1[0], h1[1], h1[2], h1[3]}, o[d0], 0, 0, 0);   \
        o[d0] = __builtin_amdgcn_mfma_f32_32x32x16_bf16(pa2, (bf16x8){l2[0], l2[1], l2[2], l2[3], h2[0], h2[1], h2[2], h2[3]}, o[d0], 0, 0, 0);   \
        o[d0] = __builtin_amdgcn_mfma_f32_32x32x16_bf16(pa3, (bf16x8){l3[0], l3[1], l3[2], l3[3], h3[0], h3[1], h3[2], h3[3]}, o[d0], 0, 0, 0); } while (0)
    PV_D0(0); PV_D0(1); PV_D0(2); PV_D0(3);
#undef PV_D0
#undef TRRD
}
struct BlockRef { const bf16* Q; const bf16* K; const bf16* V; bf16* O; int P0; };
struct Seam { bf16x8 qr[8]; bf16x8 st_v0, st_v1, st_k0, st_k1; };
#define ROW(p, k0, rr) ((p) + (size_t)((k0) + (rr)) * PITCH + sc)
#define VMW() asm volatile("s_waitcnt vmcnt(0)" ::: "memory")
#define VMWN(n) asm volatile("s_waitcnt vmcnt(%0)" :: "i"(n) : "memory")
#define SLOAD_H(Kp, Vp, k0) do { S.st_v0 = load8<bf16>(ROW(Vp, k0, sr)); S.st_v1 = load8<bf16>(ROW(Vp, k0, 32 + sr));              \
                         S.st_k0 = load8<bf16>(ROW(Kp, k0, sr)); S.st_k1 = load8<bf16>(ROW(Kp, k0, 32 + sr)); } while (0)
#define SWRITE_HK(bf) do { *(bf16x8*)(K_lds + (bf) * SHM_K + kws) = S.st_k0; *(bf16x8*)(K_lds + (bf) * SHM_K + kws + 32 * 256) = S.st_k1; } while (0)
#define SWRITE_HV(bf) do { *(bf16x8*)(V_lds + (bf) * SHM_V + vst0) = S.st_v0; *(bf16x8*)(V_lds + (bf) * SHM_V + vst1) = S.st_v1; } while (0)
#define SWRITE_H(bf) do { SWRITE_HV(bf); SWRITE_HK(bf); } while (0)
__device__ __forceinline__ void prime(const BlockRef& cur, char* lds, Seam& S) {
    const int tid = threadIdx.x, wid = __builtin_amdgcn_readfirstlane(tid >> 6), lane = tid & 63, r32 = lane & 31, hi = lane >> 5;
    const int sr = tid >> 4, sc = (tid & 15) * 8, kws = KSWZ(sr, sc * 2); char* K_lds = lds + 2 * SHM_V;
#pragma unroll
    for (int d0 = 0; d0 < 8; ++d0) S.qr[d0] = load8<bf16>(cur.Q + (size_t)(wid * QBLK + r32) * PITCH + d0 * 16 + hi * 8);
    SLOAD_H(cur.K, cur.V, 0); VMW(); SWRITE_HK(0);
    __syncthreads();
}
__device__ __forceinline__ void block(const BlockRef& cur, const BlockRef& nxt, int skv, char* lds, Seam& S) {
    const int W = 1 << 30;
    const int tid = threadIdx.x, wid = __builtin_amdgcn_readfirstlane(tid >> 6), lane = tid & 63, r32 = lane & 31, hi = lane >> 5;
    const int j_lo = 0;
    int j_hi = (cur.P0 + QB - 1) / KVBLK + 1; if (j_hi > skv / KVBLK) j_hi = skv / KVBLK;
    const int NT = j_hi - j_lo;
    const int kbn = 0;
    const int qlo = cur.P0 + wid * QBLK, qm = qlo + r32 - 4 * hi;
    char* V_lds = lds; char* K_lds = lds + 2 * SHM_V;
    float* ws = (float*)(lds + 2 * SHM_V + 2 * SHM_K) + wid * 64; float* li_l = ws, * al_l = ws + 32;
    float m_reg = -1e30f, l_reg = 0; f32x16 o[4] = {};
    const int sr = tid >> 4, sc = (tid & 15) * 8, vst0 = v_st(sr, sc), vst1 = v_st(32 + sr, sc), kws = KSWZ(sr, sc * 2);
    const int vb0 = (int)(uintptr_t)V_lds + v_rd_base(lane);
    const bf16* Kh = cur.K; const bf16* Vh = cur.V;
#define RESC(a) do { if (__any((a) < 1.f)) { if (hi == 0) al_l[r32] = (a); asm volatile("s_waitcnt lgkmcnt(0)" ::: "memory");              \
                     for (int d_ = 0; d_ < 4; ++d_) for (int r = 0; r < 16; ++r) o[d_][r] *= al_l[crow(r, hi)]; } } while (0)
#define KBASE(t) ((j_lo + (t)) * KVBLK)
#define ACT(t) (KBASE(t) <= qlo + QBLK - 1 && KBASE(t) + KVBLK - 1 >= qlo - W + 1)
#define MASKT(P0_, P1_, t) do { const int kb_ = KBASE(t); if ((!SK || ACT(t)) && (kb_ + KVBLK - 1 > qlo || kb_ <= qlo + QBLK - 1 - W)) mask_tile(P0_, P1_, qm - kb_, (unsigned)W); } while (0)
    constexpr int NQL = 8;
    constexpr bool SK = false;
#define SEAM_K0() do { VMWN(NQL); SWRITE_HK(0); SBAR(); } while (0)
    f32x16 pA0, pA1, pB0, pB1; float mnA, mnB, alA, alB; bf16x8 pa0, pa1, pa2, pa3;
    SWRITE_HV(0); SBAR();
    if (NT > 1) { SLOAD_H(Kh, Vh, KBASE(1)); }
    SBAR(); qkt<0, SK>(pA0, pA1, K_lds, r32, hi, S.qr, ACT(0));
    MASKT(pA0, pA1, 0); partialSM(pA0, pA1, m_reg, mnA, alA);
    if (NT > 1) { VMW(); SWRITE_HK(1); }
    __syncthreads();
#define HALF_STEP(PX0, PX1, mnX, alX, PY0, PY1, alY, t, KB, VB, SB) do {                                                      \
        SWRITE_HV(KB);     \
        SBAR(); qkt<KB, SK>(PX0, PX1, K_lds, r32, hi, S.qr, ACT(t));                                             \
        finishSM(PY0, PY1, alY, l_reg, pa0, pa1, pa2, pa3); SBAR();                                                           \
        if ((t) + 1 < NT) { SLOAD_H(Kh, Vh, KBASE((t) + 1)); SBAR(); }                                               \
        pv_tile<VB, SK>(o, vb0, pa0, pa1, pa2, pa3, ACT((t) - 1)); MASKT(PX0, PX1, (t)); partialSM(PX0, PX1, m_reg, mnX, alX);                                        \
          \
        if ((t) + 1 < NT) { VMW(); SWRITE_HK(SB); }                                                                          \
        RESC(alX); __syncthreads(); } while (0)
    for (int t = 1; t + 1 < NT; t += 2) {
        HALF_STEP(pB0, pB1, mnB, alB, pA0, pA1, alA, t, 1, 0, 0);
        HALF_STEP(pA0, pA1, mnA, alA, pB0, pB1, alB, t + 1, 0, 1, 1);
    }
    const bool even = (NT & 1) == 0;
    if (even) { SWRITE_HV(1); SBAR(); qkt<1, SK>(pB0, pB1, K_lds, r32, hi, S.qr, ACT(NT - 1)); SBAR(); }
    SLOAD_H(nxt.K, nxt.V, kbn); SBAR();
#pragma unroll
    for (int d0 = 0; d0 < 8; ++d0) S.qr[d0] = load8<bf16>(nxt.Q + (size_t)(wid * QBLK + r32) * PITCH + d0 * 16 + hi * 8);
    SBAR();
    finishSM(pA0, pA1, alA, l_reg, pa0, pa1, pa2, pa3); SBAR();
    pv_tile<0, SK>(o, vb0, pa0, pa1, pa2, pa3, ACT(even ? NT - 2 : NT - 1));
    if (even) { MASKT(pB0, pB1, NT - 1); partialSM(pB0, pB1, m_reg, mnB, alB); __syncthreads(); RESC(alB);
        finishSM(pB0, pB1, alB, l_reg, pa0, pa1, pa2, pa3); SBAR(); pv_tile<1, SK>(o, vb0, pa0, pa1, pa2, pa3, ACT(NT - 1)); }
    SBAR(); SEAM_K0();
    if (hi == 0) li_l[r32] = l_reg; asm volatile("s_waitcnt lgkmcnt(0)" ::: "memory");
    float rli[16];
#pragma unroll
    for (int r = 0; r < 16; ++r) rli[r] = __builtin_amdgcn_rcpf(li_l[crow(r, hi)]);
    bf16* Ow = cur.O + (size_t)(wid * QBLK) * PITCH;
#pragma unroll
    for (int r = 0; r < 16; ++r) { const int orow = crow(r, hi);
#pragma unroll
        for (int d0 = 0; d0 < 4; ++d0) { const float v = o[d0][r] * rli[r];
            const float vn = __shfl_xor(v, 1);
            if ((r32 & 1) == 0) *(unsigned*)(Ow + (size_t)orow * PITCH + d0 * 32 + r32) = cvtpk(v, vn); } }
    __syncthreads();
#undef RESC
#undef KBASE
#undef ACT
#undef MASKT
#undef SEAM_K0
#undef HALF_STEP
}
#undef ROW
#undef VMW
#undef VMWN
#undef SLOAD_H
#undef SWRITE_HK
#undef SWRITE_HV
#undef SWRITE_H
#undef SBAR
#undef KSWZ
}
#define LAS __attribute__((address_space(3)))
typedef unsigned short bf16_t;
typedef float f32x4 __attribute__((ext_vector_type(4)));
typedef float f32x16 __attribute__((ext_vector_type(16)));
typedef short bf16x8 __attribute__((ext_vector_type(8)));
typedef unsigned u32x4 __attribute__((ext_vector_type(4)));
typedef unsigned u32x2 __attribute__((ext_vector_type(2)));
constexpr int DM = 4096, TPAD = 4224, TVALID = 4112, NMETA = 16, MX = 8192, MIN_ROWS = 8448, INW = 10240, DFF = 11008, NGU = 22016, NCH = 65;
constexpr float EPS = 1e-6f, L2E = 1.4426950408889634f;
constexpr size_t MiB = 1u << 20;
constexpr size_t WS_WIN = 16 * MiB, WS_WOUT = 96 * MiB, WS_WGU = 128 * MiB, WS_WDN = 300 * MiB, WS_SMALL = 386 * MiB, WS_R1 = 400 * MiB, WS_R2 = 466 * MiB, WS_R3 = 638 * MiB, WS_R4 = 770 * MiB, WS_END = 834 * MiB;
constexpr size_t SM_COS = 0, SM_SIN = 2 * MiB, SM_WTR = 4 * MiB, SM_WTI = 4 * MiB + 512 * 1024, SM_SPL = 5 * MiB, SM_SSQ1 = 6 * MiB, SM_SSQ2 = 8 * MiB, SM_AAGG = 10 * MiB, SM_BAGG = 12 * MiB;
constexpr size_t QKV_ELEMS = (size_t)2 * TPAD * 2048;
constexpr int LDS_BYTES = 147456;
constexpr int NPHASE = 9;
constexpr int WDN_EARLY = 4864;
#ifndef PROBE_REP
#define PROBE_REP -1
#endif
#ifndef PROBE_SUB
#define PROBE_SUB 0
#endif
#ifndef MK_N_LAUNCHES
#define MK_N_LAUNCHES 1
#endif

__device__ __forceinline__ float wave_sum(float v) {
#pragma unroll
    for (int o = 1; o < 64; o <<= 1) v += __shfl_xor(v, o);
    return v;
}
__device__ __forceinline__ unsigned pk2(float lo, float hi) { return pg8::cvt_pk_bf16(lo, hi); }
__device__ __forceinline__ float bf_lo(unsigned w) { return __uint_as_float(w << 16); }
__device__ __forceinline__ float bf_hi(unsigned w) { return __uint_as_float(w & 0xffff0000u); }
__device__ __forceinline__ float sigmoidf_(float x) { return __builtin_amdgcn_rcpf(1.f + __builtin_amdgcn_exp2f(-L2E * x)); }
__device__ __forceinline__ int crow16(int r, int hi) { return (r & 3) + 8 * (r >> 2) + 4 * hi; }

__device__ __forceinline__ int map_row(int mode, int n0) {
    if (mode == 1) { if (n0 < 4096) { const int g = (n0 >> 6) & 3, g2 = (g == 1) ? 2 : (g == 2) ? 1 : g; return (n0 & ~255) + (g2 << 6) + (n0 & 63); } return n0; }
    if (mode == 2) return ((n0 >> 7) << 8) + (n0 & 127);
    if (mode == 3) return ((n0 >> 7) << 8) + 128 + (n0 & 127);
    return n0;
}
__device__ __forceinline__ void transpose_item(const float* __restrict__ W, int K, int N, bf16_t* __restrict__ WT, int mode, LAS float* scr, int item, int lane) {
    const int nblk = N / 64, kb = item / nblk, nb = item % nblk, k0 = 64 * kb, n0 = 64 * nb;
    const int rbase = map_row(mode, n0), l15 = lane & 15, lq = lane >> 4;
    const float* src = W + (size_t)(k0 + lq) * N + n0 + 4 * l15;
    f32x4 v[16];
#pragma unroll
    for (int i = 0; i < 16; ++i) v[i] = __builtin_nontemporal_load((const f32x4*)(src + (size_t)(4 * i) * N));
#pragma unroll
    for (int i = 0; i < 16; ++i) { LAS float* d = scr + (4 * i + lq) * 65 + 4 * l15; d[0] = v[i][0]; d[1] = v[i][1]; d[2] = v[i][2]; d[3] = v[i][3]; }
    asm volatile("s_waitcnt lgkmcnt(0)" ::: "memory");
    const int c = lane & 7, nr = lane >> 3;
#pragma unroll
    for (int j = 0; j < 8; ++j) { const int n = nr + 8 * j; const LAS float* s = scr + (8 * c) * 65 + n;
        u32x4 o; o.x = pk2(s[0 * 65], s[1 * 65]); o.y = pk2(s[2 * 65], s[3 * 65]); o.z = pk2(s[4 * 65], s[5 * 65]); o.w = pk2(s[6 * 65], s[7 * 65]);
        *(u32x4*)(WT + (size_t)(rbase + n) * K + k0 + 8 * c) = o; }
    asm volatile("s_waitcnt lgkmcnt(0)" ::: "memory");
}
template <int K, int N> __device__ __forceinline__ void tr_load(const float* __restrict__ W, int item, int lane, f32x4 (&v)[16], const float* __restrict__ gs = nullptr) {
    constexpr int nblk = N / 64; const int kb = item / nblk, nb = item % nblk;
    const float* src = W + (size_t)(64 * kb + (lane >> 4)) * N + 64 * nb + 4 * (lane & 15);
#pragma unroll
    for (int i = 0; i < 16; ++i) v[i] = __builtin_nontemporal_load((const f32x4*)(src + (size_t)(4 * i) * N));
    if (gs) {
        float sc[16];
#pragma unroll
        for (int i = 0; i < 16; ++i) sc[i] = gs[64 * kb + 4 * i + (lane >> 4)];
#pragma unroll
        for (int i = 0; i < 16; ++i) v[i] = v[i] * sc[i];
    }
}
template <int K, int N> __device__ __forceinline__ void tr_store(bf16_t* __restrict__ WT, int mode, LAS float* scr, int item, int lane, const f32x4 (&v)[16]) {
    constexpr int nblk = N / 64; const int kb = item / nblk, nb = item % nblk, k0 = 64 * kb, l15 = lane & 15, lq = lane >> 4;
    const int rbase = map_row(mode, 64 * nb);
#pragma unroll
    for (int i = 0; i < 16; ++i) { LAS float* d = scr + (4 * i + lq) * 65 + 4 * l15; d[0] = v[i][0]; d[1] = v[i][1]; d[2] = v[i][2]; d[3] = v[i][3]; }
    asm volatile("s_waitcnt lgkmcnt(0)" ::: "memory");
    const int c = lane & 7, nr = lane >> 3;
#pragma unroll
    for (int j = 0; j < 8; ++j) { const int n = nr + 8 * j; const LAS float* sp = scr + (8 * c) * 65 + n;
        u32x4 o; o.x = pk2(sp[0 * 65], sp[1 * 65]); o.y = pk2(sp[2 * 65], sp[3 * 65]); o.z = pk2(sp[4 * 65], sp[5 * 65]); o.w = pk2(sp[6 * 65], sp[7 * 65]);
        *(u32x4*)(WT + (size_t)(rbase + n) * K + k0 + 8 * c) = o; }
    asm volatile("s_waitcnt lgkmcnt(0)" ::: "memory");
}
template <int K, int N> __device__ __forceinline__ void tr_run(const float* __restrict__ W1, const float* __restrict__ W2, int split, bf16_t* __restrict__ WT, int mode1, int mode2,
                                                               LAS float* scr, int first, int count, int stride, int lane, const float* __restrict__ gs = nullptr) {
    for (int it = first; it < count; it += 2 * stride) {
        const int itb = it + stride; const bool two = itb < count;
        f32x4 va[16], vb[16];
        tr_load<K, N>(it < split ? W1 : W2, it < split ? it : it - split, lane, va, gs);
        if (two) tr_load<K, N>(itb < split ? W1 : W2, itb < split ? itb : itb - split, lane, vb, gs);
        tr_store<K, N>(WT, it < split ? mode1 : mode2, scr, it < split ? it : it - split, lane, va);
        if (two) tr_store<K, N>(WT, itb < split ? mode1 : mode2, scr, itb < split ? itb : itb - split, lane, vb);
    }
}
__device__ __forceinline__ void rms_row_bf16(const float* __restrict__ xrow, const float* __restrict__ g, bf16_t* __restrict__ orow, int lane) {
    const f32x4* xr = (const f32x4*)xrow + lane; f32x4 v[16]; float s = 0.f;
#pragma unroll
    for (int j = 0; j < 16; ++j) { v[j] = __builtin_nontemporal_load(xr + 64 * j); s += (v[j][0] * v[j][0] + v[j][1] * v[j][1]) + (v[j][2] * v[j][2] + v[j][3] * v[j][3]); }
    const float rs = rsqrtf(wave_sum(s) * (1.f / DM) + EPS);
    const f32x4* gp = (const f32x4*)g + lane; u32x2* o8 = (u32x2*)orow + lane;
#pragma unroll
    for (int j = 0; j < 16; ++j) { const f32x4 gg = gp[64 * j]; u32x2 w; w.x = pk2(v[j][0] * rs * gg[0], v[j][1] * rs * gg[1]); w.y = pk2(v[j][2] * rs * gg[2], v[j][3] * rs * gg[3]); o8[64 * j] = w; }
}

#define XB_TMO      128
#define XB_XCNT(j)  (256  + 64 * (j))
#define XB_XSUB(j)  (1280 + 64 * (j))
#define XB_XGEN(j)  (2304 + 64 * (j))
#define XB_TOP      3328
#define XB_TOPGEN   3392
#define XCD_BAR_WORDS 3456
#define XB_SPIN_CAP (1u << 18)

__device__ __forceinline__ unsigned xb_ld(unsigned* p)              { return __hip_atomic_load(p, __ATOMIC_RELAXED, __HIP_MEMORY_SCOPE_AGENT); }
__device__ __forceinline__ unsigned xb_add(unsigned* p, unsigned v) { return __hip_atomic_fetch_add(p, v, __ATOMIC_RELAXED, __HIP_MEMORY_SCOPE_AGENT); }
__device__ __forceinline__ unsigned xb_xcc_id() { return (unsigned)__builtin_amdgcn_s_getreg((3 << 11) | 20) & 0xFu; }
#define XB_SPIN(cond, bar) do { unsigned _sp = 0; while (cond) { __builtin_amdgcn_s_sleep(1); \
    if ((++_sp & 255u) == 0u) { if (xb_ld(&(bar)[XB_TMO])) break; if (_sp > XB_SPIN_CAP) { atomicAdd(&(bar)[XB_TMO], 1u); break; } } } } while (0)

struct XcdBarrier {
    unsigned* bar; unsigned x;
    volatile LAS unsigned* st;
};

__device__ __forceinline__ XcdBarrier xcd_barrier_post(unsigned* bar, volatile LAS unsigned* st) {
    XcdBarrier b; b.bar = bar; b.x = xb_xcc_id(); b.st = st;
    if (threadIdx.x == 0) (void)xb_add(&bar[XB_XCNT(b.x)], 1u);
    return b;
}
__device__ __forceinline__ void xcd_barrier_complete(unsigned* bar, unsigned x, unsigned& nloc, unsigned& nx) {
    const unsigned G = gridDim.x * gridDim.y * gridDim.z;
    unsigned sum, cnt, mine, sp = 0u;
    for (;;) {
        sum = 0u; cnt = 0u; mine = 0u;
#pragma unroll
        for (unsigned j = 0; j < 16; ++j) { const unsigned c = xb_ld(&bar[XB_XCNT(j)]); sum += c; cnt += (c > 0u) ? 1u : 0u; mine = (j == x) ? c : mine; }
        if (sum == G) break;
        __builtin_amdgcn_s_sleep(1);
        if ((++sp & 255u) == 0u) { if (xb_ld(&bar[XB_TMO])) break; if (sp > XB_SPIN_CAP) { atomicAdd(&bar[XB_TMO], 1u); break; } }
    }
    nloc = mine > 0u ? mine : 1u; nx = cnt > 0u ? cnt : 1u;
}

__device__ __forceinline__ void xcd_barrier(const XcdBarrier& b) {
    asm volatile("s_waitcnt vmcnt(0)" ::: "memory");
    __syncthreads();
    if (threadIdx.x == 0) {
        unsigned* bar = b.bar;
        __builtin_amdgcn_s_waitcnt(0);
        unsigned nloc = b.st[0], nx = b.st[1];
        if (nloc == 0u) { xcd_barrier_complete(bar, b.x, nloc, nx); b.st[0] = nloc; b.st[1] = nx; }
        const unsigned old = xb_add(&bar[XB_XSUB(b.x)], 1u);
        const unsigned gen = old / nloc;
        if (old + 1u == (gen + 1u) * nloc) {
            __builtin_amdgcn_fence(__ATOMIC_RELEASE, "agent");
            asm volatile("s_waitcnt vmcnt(0)" ::: "memory");
            const unsigned og = xb_add(&bar[XB_TOP], 1u);
            const unsigned tg = og / nx;
            if (og + 1u == (tg + 1u) * nx) xb_add(&bar[XB_TOPGEN], 1u);
            else XB_SPIN(xb_ld(&bar[XB_TOPGEN]) == tg, bar);
            __builtin_amdgcn_fence(__ATOMIC_ACQUIRE, "agent");
            xb_add(&bar[XB_XGEN(b.x)], 1u);
            asm volatile("s_waitcnt vmcnt(0)" ::: "memory");
        } else {
            XB_SPIN(xb_ld(&bar[XB_XGEN(b.x)]) == gen, bar);
            __builtin_amdgcn_fence(__ATOMIC_ACQUIRE, "agent");
            asm volatile("s_waitcnt vmcnt(0)" ::: "memory");
        }
    }
    __syncthreads();
}

struct SubOrder { pg8::StaticOrder B; int i0, n;
    __device__ __forceinline__ bool next(int i, pg8::Unit& u) const { return i < n && B.next(i0 + i, u); }
    __device__ __forceinline__ void a_ready(const pg8::Unit&) const {}
    __device__ __forceinline__ void done(const pg8::Unit&) const {}
};
struct Params { const float* in[23]; float* out; unsigned char* ws; int ph_lo, ph_hi; };
typedef const __attribute__((address_space(4))) Params* KP;
__device__ __forceinline__ KP kargs() { KP q = (KP)__builtin_amdgcn_kernarg_segment_ptr(); asm volatile("" : "+s"(q)); return q; }

__global__ void __launch_bounds__(512, 2) fwd_mega(Params P_by_kernarg) {
    extern __shared__ __attribute__((aligned(16))) unsigned char lds[];
    cg::grid_group grid = cg::this_grid();
    const int tid = threadIdx.x, lane = tid & 63, wave = __builtin_amdgcn_readfirstlane(tid >> 6);
    const int G = gridDim.x, bx = blockIdx.x, vcu = (G % 8 == 0) ? (bx % 8) * (G / 8) + bx / 8 : bx;
    const int gw = vcu * 8 + wave, NGW = G * 8;
#define Win_t  ((bf16_t*)(ws + WS_WIN))
#define Wout_t ((bf16_t*)(ws + WS_WOUT))
#define Wgu_t  ((bf16_t*)(ws + WS_WGU))
#define Wdn_t  ((bf16_t*)(ws + WS_WDN))
#define cosT   ((float*)(ws + WS_SMALL + SM_COS))
#define sinT   ((float*)(ws + WS_SMALL + SM_SIN))
#define WTr    ((bf16_t*)(ws + WS_SMALL + SM_WTR))
#define WTi    ((bf16_t*)(ws + WS_SMALL + SM_WTI))
#define spl    ((float*)(ws + WS_SMALL + SM_SPL))
#define ssq1   ((float*)(ws + WS_SMALL + SM_SSQ1))
#define ssq2   ((float*)(ws + WS_SMALL + SM_SSQ2))
#define Aagg   ((float*)(ws + WS_SMALL + SM_AAGG))
#define Bagg   ((float*)(ws + WS_SMALL + SM_BAGG))
#define Ubuf   ((bf16_t*)(ws + WS_R1))
#define QKV    ((bf16_t*)(ws + WS_R2))
#define Qb     (QKV)
#define Kb     (QKV + QKV_ELEMS)
#define Vb     (QKV + 2 * QKV_ELEMS)
#define XRb    (QKV + 3 * QKV_ELEMS)
#define GTb    (QKV + 4 * QKV_ELEMS)
#define Pc     ((bf16_t*)(ws + WS_R3))
#define Hloc   ((bf16_t*)(ws + WS_R3) + QKV_ELEMS)
#define Mixed  ((bf16_t*)(ws + WS_R3))
#define Opart  ((bf16_t*)(ws + WS_R4))
#define H1b    ((bf16_t*)(ws + WS_R4))
#define RS2    ((float*)(ws + WS_SMALL + SM_SPL + 65536))
#define RS1    ((float*)(ws + WS_SMALL + SM_SPL + 131072))
    const int lo = kargs()->ph_lo, hi_ph = kargs()->ph_hi;
    volatile LAS unsigned* MISCW = (volatile LAS unsigned*)((LAS unsigned char*)lds + (LDS_BYTES - 256));
    const bool fast = (lo == 0 && hi_ph == NPHASE);
    unsigned* const barw = (unsigned*)(kargs()->ws + 4096);
    if (tid < 2) MISCW[tid] = 0u;
    __syncthreads();
    XcdBarrier xbar; xbar.bar = barw; xbar.x = 0; xbar.st = MISCW;
    if (fast) xbar = xcd_barrier_post(barw, MISCW);
#define IN(k) (lo <= (k) && (k) < hi_ph)
#define SEAM(k) do { if (IN(k) && IN((k) + 1)) { if (fast) xcd_barrier(xbar); else grid.sync(); } } while (0)

    if (IN(0)) {
        const KP KA = kargs(); unsigned char* const ws = KA->ws;
        LAS float* scr = (LAS float*)((LAS unsigned char*)lds + wave * 16640);
        constexpr int I_IN = 64 * 160;
        tr_run<DM, INW>(KA->in[3], KA->in[3], I_IN, Win_t, 1, 1, scr, gw, I_IN, NGW, lane, KA->in[2]);
        for (int m = gw; m < MX + NMETA; m += NGW) {
            const float* xrow = (m < MX) ? KA->in[0] + (size_t)m * DM : KA->in[1] + (size_t)(m - MX) * DM;
            const f32x4* xr = (const f32x4*)xrow + lane; f32x4 v[16]; float sq = 0.f;
#pragma unroll
            for (int j = 0; j < 16; ++j) { v[j] = __builtin_nontemporal_load(xr + 64 * j); sq += (v[j][0] * v[j][0] + v[j][1] * v[j][1]) + (v[j][2] * v[j][2] + v[j][3] * v[j][3]); }
            const float rs = rsqrtf(wave_sum(sq) * (1.f / DM) + EPS); if (lane == 0) RS1[m] = rs;
            u32x2* o8 = (u32x2*)(Ubuf + (size_t)m * DM) + lane;
#pragma unroll
            for (int j = 0; j < 16; ++j) { u32x2 w; w.x = pk2(v[j][0], v[j][1]); w.y = pk2(v[j][2], v[j][3]); o8[64 * j] = w; }
        }
        const int gt = vcu * 512 + tid, NGT = G * 512;
        for (int idx = gt; idx < TPAD * 64; idx += NGT) {
            const int pos = idx >> 6, i = idx & 63;
            const float inv = exp2f(-(float)i * (13.287712379549449f / 64.f));
            double rev = (double)pos * (double)inv * 0.15915494309189535; rev -= __builtin_floor(rev);
            cosT[idx] = __builtin_amdgcn_cosf((float)rev); sinT[idx] = __builtin_amdgcn_sinf((float)rev);
        }
        for (int o = gt; o < 2 * 16 * 128 * 128; o += NGT) {
            const int which = o >> 18, oo = o & 262143, hd = oo >> 14, j = (oo >> 7) & 127, i = oo & 127;
            const float v = (which ? KA->in[13] : KA->in[11])[(hd << 14) + (i << 7) + j];
            (which ? WTi : WTr)[oo] = (bf16_t)(pk2(v, 0.f) & 0xffffu);
        }
        for (int c = gt; c < 2048; c += NGT) { const float lam = KA->in[15][c]; const float sp = (lam > 15.f) ? expf(-lam) : log1pf(expf(-lam)); spl[c] = 8.f * sp * L2E; }
        { constexpr int PADROWS = TPAD - TVALID, CH16 = 2048 / 8;
          for (int idx = gt; idx < 5 * 2 * PADROWS * CH16; idx += NGT) { const int ch = idx % CH16, rr = idx / CH16, prow = rr % PADROWS, bb = (rr / PADROWS) & 1, buf = rr / (2 * PADROWS);
              *(u32x4*)(QKV + (size_t)buf * QKV_ELEMS + ((size_t)(bb * TPAD + TVALID + prow)) * 2048 + ch * 8) = (u32x4){0u, 0u, 0u, 0u}; } }
    }
    SEAM(0);
    if (IN(1)) {
        const KP KA = kargs(); unsigned char* const ws = KA->ws;
        if (vcu < 160) {
            const int kq = wave & 3, item = vcu * 2 + (wave >> 2), pn = item >> 3, jg = item & 7, l15 = lane & 15, fq = lane >> 4;
            const bf16_t* b0p = Win_t + ((size_t)(pn * 256 + jg * 16 + l15)) * DM + kq * 1024 + fq * 8; const bf16_t* b1p = b0p + (size_t)128 * DM;
            const bf16_t* ap = Ubuf + ((size_t)(MX + l15)) * DM + kq * 1024 + fq * 8;
            f32x4 c0 = (f32x4){0.f, 0.f, 0.f, 0.f}, c1 = c0;
#pragma unroll 8
            for (int ks = 0; ks < 32; ++ks) { const bf16x8 w0 = *(const bf16x8*)(b0p + ks * 32), w1 = *(const bf16x8*)(b1p + ks * 32), av = *(const bf16x8*)(ap + ks * 32);
                c0 = __builtin_amdgcn_mfma_f32_16x16x32_bf16(w0, av, c0, 0, 0, 0); c1 = __builtin_amdgcn_mfma_f32_16x16x32_bf16(w1, av, c1, 0, 0, 0); }
            LAS f32x4* red = (LAS f32x4*)lds;
            red[(wave * 2 + 0) * 64 + lane] = c0; red[(wave * 2 + 1) * 64 + lane] = c1;
            __syncthreads();
            if (kq == 0) {
#pragma unroll
                for (int q = 1; q < 4; ++q) { c0 += red[((wave + q) * 2 + 0) * 64 + lane]; c1 += red[((wave + q) * 2 + 1) * 64 + lane]; }
                { const float rr = RS1[MX + l15]; c0 = c0 * rr; c1 = c1 * rr; }
                const int sect = pn >> 3, hd = pn & 7, pos = l15, j = jg * 16 + 4 * fq;
                bf16_t* buf = QKV + (size_t)sect * QKV_ELEMS + (size_t)pos * 2048 + hd * 256;
                if (sect < 2) { const int comp = j >> 6, i0 = j & 63;
                    const f32x4 cs = *(const f32x4*)(cosT + pos * 64 + i0), sn = *(const f32x4*)(sinT + pos * 64 + i0);
                    const f32x4 o1 = c0 * cs - c1 * sn, o2 = c1 * cs + c0 * sn;
                    u32x2 w1, w2; w1.x = pk2(o1[0], o1[1]); w1.y = pk2(o1[2], o1[3]); w2.x = pk2(o2[0], o2[1]); w2.y = pk2(o2[2], o2[3]);
                    bf16_t* p = buf + comp * 128 + i0;
                    *(u32x2*)p = w1; *(u32x2*)(p + 64) = w2; *(u32x2*)(p + (size_t)TPAD * 2048) = w1; *(u32x2*)(p + (size_t)TPAD * 2048 + 64) = w2;
                } else { u32x2 w1, w2; w1.x = pk2(c0[0], c0[1]); w1.y = pk2(c0[2], c0[3]); w2.x = pk2(c1[0], c1[1]); w2.y = pk2(c1[2], c1[3]);
                    bf16_t* p = buf + j;
                    *(u32x2*)p = w1; *(u32x2*)(p + 128) = w2; *(u32x2*)(p + (size_t)TPAD * 2048) = w1; *(u32x2*)(p + (size_t)TPAD * 2048 + 128) = w2; }
            }
            __syncthreads();
        }
        pg8::Gemm g{Ubuf, Win_t, MX, INW, DM}; pg8::StaticOrder S0; S0.init(MX, INW, G, bx);
        pg8::EpiIn E{QKV, cosT, sinT, RS1};
        const int NU = (S0.nwg + G - 1) / G, cls = bx % NU;
        { SubOrder S{S0, 0, cls}; pg8::gemm_phase<pg8::EpiIn, SubOrder, true, true>((LAS unsigned char*)lds, g, S, E); }
        {
            __syncthreads();
            const KP KA = kargs(); unsigned char* const ws = KA->ws;
            LAS float* scr = (LAS float*)((LAS unsigned char*)lds + wave * 16640);
            constexpr int I_OUT = 64 * 64, I_G = 64 * 172, I_D = WDN_EARLY, NDEF = I_OUT + 2 * I_G + I_D;
            (void)NDEF;
            tr_run<DM, DM>(KA->in[16], KA->in[16], I_OUT, Wout_t, 0, 0, scr, gw, I_OUT, NGW, lane);
            tr_run<DM, DFF>(KA->in[19], KA->in[20], I_G, Wgu_t, 2, 3, scr, gw, 2 * I_G, NGW, lane, KA->in[18]);
            if (I_D > 0) tr_run<DFF, DM>(KA->in[21], KA->in[21], I_D, Wdn_t, 0, 0, scr, gw, I_D, NGW, lane);
            __syncthreads();
        }
        { const KP KA = kargs(); unsigned char* const ws = KA->ws;
          pg8::Gemm g2{Ubuf, Win_t, MX, INW, DM}; pg8::StaticOrder S1; S1.init(MX, INW, G, bx); pg8::EpiIn E2{QKV, cosT, sinT, RS1};
          SubOrder S{S1, cls, NU - cls}; pg8::gemm_phase<pg8::EpiIn, SubOrder, true, true>((LAS unsigned char*)lds, g2, S, E2); }
    }
    SEAM(1);
    if (IN(2)) {
        const KP KA = kargs(); unsigned char* const ws = KA->ws;
        LAS bf16_t* XB = (LAS bf16_t*)lds;
        LAS float* A_s = (LAS float*)((LAS unsigned char*)lds + 17408); LAS float* B_s = A_s + 64 * 129;
        LAS float* PAR = (LAS float*)((LAS unsigned char*)lds + 83456); LAS float* SEG = PAR + 1024;
#define LDS_BAR() asm volatile("s_waitcnt lgkmcnt(0)\n\ts_barrier" ::: "memory")
        {
        const int chg = tid & 15, rg = tid >> 4, tt = wave & 1, jt = wave >> 1, l31 = lane & 31, hi = lane >> 5;
        int loaded_hd = -1; bf16x8 wrf[8], wif[8]; u32x4 xw[5];
#define LRU_LOADX(it_) do { const int hd_ = (it_) & 15, bc_ = (it_) >> 4, c_ = bc_ % NCH, b_ = bc_ / NCH; _Pragma("unroll") for (int k = 0; k < 5; ++k) { const int pos = c_ * 64 + 2 * rg - 3 + k; \
            xw[k] = (u32x4){0u, 0u, 0u, 0u}; if (pos >= 0) xw[k] = *(const u32x4*)(XRb + ((size_t)(b_ * TPAD + pos)) * 2048 + hd_ * 128 + chg * 8); } } while (0)
        for (int rep_ = 0; rep_ < (PROBE_SUB == 1 ? 2 : 1); ++rep_) {
        if (vcu < 2 * NCH * 16) LRU_LOADX(vcu);
        for (int item = vcu; item < 2 * NCH * 16; item += G) {
            const int hd = item & 15, bc = item >> 4, c64 = bc % NCH, b = bc / NCH, t0 = c64 * 64;
            if (hd != loaded_hd) {
                __syncthreads();
                for (int i = tid; i < 1024; i += 512) { const int k = i >> 7, j = i & 127; float v;
                    if (k < 4) v = KA->in[9][k * 2048 + hd * 128 + j]; else if (k == 4) v = KA->in[10][hd * 128 + j]; else if (k == 5) v = KA->in[12][hd * 128 + j]; else if (k == 6) v = KA->in[14][hd * 128 + j]; else v = spl[hd * 128 + j];
                    PAR[i] = v; }
                const bf16_t* wrp = WTr + ((size_t)(hd * 128 + jt * 32 + l31)) * 128 + hi * 8; const bf16_t* wip = WTi + ((size_t)(hd * 128 + jt * 32 + l31)) * 128 + hi * 8;
#pragma unroll
                for (int kk = 0; kk < 8; ++kk) { wrf[kk] = *(const bf16x8*)(wrp + kk * 16); wif[kk] = *(const bf16x8*)(wip + kk * 16); }
                loaded_hd = hd;
                __syncthreads();
            }
            { float xin[5][8];
#pragma unroll
              for (int k = 0; k < 5; ++k) { const u32x4 w = xw[k];
                  xin[k][0] = bf_lo(w.x); xin[k][1] = bf_hi(w.x); xin[k][2] = bf_lo(w.y); xin[k][3] = bf_hi(w.y); xin[k][4] = bf_lo(w.z); xin[k][5] = bf_hi(w.z); xin[k][6] = bf_lo(w.w); xin[k][7] = bf_hi(w.w); }
              if (item + G < 2 * NCH * 16) LRU_LOADX(item + G);
              float o[2][8];
#pragma unroll
              for (int e = 0; e < 8; ++e) { const float cb = PAR[512 + chg * 8 + e]; o[0][e] = cb; o[1][e] = cb; }
#pragma unroll
              for (int w = 0; w < 4; ++w)
#pragma unroll
                  for (int e = 0; e < 8; ++e) { const float cw = PAR[w * 128 + chg * 8 + e]; o[0][e] += cw * xin[w][e]; o[1][e] += cw * xin[w + 1][e]; }
#pragma unroll
              for (int e2 = 0; e2 < 2; ++e2) { u32x4 w; w.x = pk2(o[e2][0], o[e2][1]); w.y = pk2(o[e2][2], o[e2][3]); w.z = pk2(o[e2][4], o[e2][5]); w.w = pk2(o[e2][6], o[e2][7]);
                  *(LAS u32x4*)(XB + (2 * rg + e2) * 136 + chg * 8) = w; } }
            LDS_BAR();
            { f32x16 accR = {}, accI = {};
              const LAS bf16_t* xbp = XB + (tt * 32 + l31) * 136 + hi * 8;
#pragma unroll
              for (int kk = 0; kk < 8; ++kk) { const bf16x8 bxv = *(const LAS bf16x8*)(xbp + kk * 16);
                  accR = __builtin_amdgcn_mfma_f32_32x32x16_bf16(wrf[kk], bxv, accR, 0, 0, 0); accI = __builtin_amdgcn_mfma_f32_32x32x16_bf16(wif[kk], bxv, accI, 0, 0, 0); }
              const int t = tt * 32 + l31;
#pragma unroll
              for (int r = 0; r < 16; ++r) { const int j = jt * 32 + crow16(r, hi);
                  const float rr = sigmoidf_(accR[r] + PAR[640 + j]), ii = sigmoidf_(accI[r] + PAR[768 + j]);
                  const float a = __builtin_amdgcn_exp2f(-PAR[896 + j] * rr), mult = __builtin_amdgcn_sqrtf(fmaxf(1.f - a * a, 0.f));
                  const float xcv = __uint_as_float(((unsigned)XB[t * 136 + j]) << 16);
                  A_s[t * 129 + j] = a; B_s[t * 129 + j] = mult * ii * xcv; } }
            LDS_BAR();
            { const int j = tid & 127, seg = tid >> 7; float hl[16], pl[16]; float h = 0.f, pc = 1.f;
#pragma unroll
              for (int t = 0; t < 16; ++t) { const float a = A_s[(16 * seg + t) * 129 + j], bb = B_s[(16 * seg + t) * 129 + j]; h = a * h + bb; pc *= a; hl[t] = h; pl[t] = pc; }
              SEG[(seg * 128 + j) * 2] = pc; SEG[(seg * 128 + j) * 2 + 1] = h;
              LDS_BAR();
              float cp = 1.f, chh = 0.f;
              for (int sg = 0; sg < seg; ++sg) { const float ap = SEG[(sg * 128 + j) * 2], bh = SEG[(sg * 128 + j) * 2 + 1]; chh = ap * chh + bh; cp *= ap; }
              const size_t go = ((size_t)(b * TPAD + t0 + 16 * seg)) * 2048 + hd * 128 + j;
#pragma unroll
              for (int t = 0; t < 16; ++t) { const float hh = hl[t] + pl[t] * chh, pp = pl[t] * cp;
                  Hloc[go + (size_t)t * 2048] = (bf16_t)(pk2(hh, 0.f) & 0xffffu); Pc[go + (size_t)t * 2048] = (bf16_t)(pk2(pp, 0.f) & 0xffffu); }
              if (seg == 3) { Aagg[(b * 66 + c64) * 2048 + hd * 128 + j] = pl[15] * cp; Bagg[(b * 66 + c64) * 2048 + hd * 128 + j] = hl[15] + pl[15] * chh; } }
        }
        __syncthreads();
        }
#undef LRU_LOADX
#undef LDS_BAR
        }
        { att::Seam S;
          auto mk = [&](int L, int pass) { att::BlockRef r; const int vh = L >> 3, x = L & 7, qb = pass ? 15 - x : x, b = vh >> 5, h = (vh >> 2) & 7, c = (vh >> 1) & 1, vf = vh & 1;
              r.Q = (const att::bf16*)(Qb + ((size_t)(b * TPAD + NMETA + qb * 256)) * 2048 + h * 256 + c * 128);
              r.K = (const att::bf16*)(Kb + ((size_t)b * TPAD) * 2048 + h * 256 + c * 128);
              r.V = (const att::bf16*)(Vb + ((size_t)b * TPAD) * 2048 + h * 256 + vf * 128);
              r.O = (att::bf16*)(Opart + (size_t)c * MX * 2048 + ((size_t)(b * 4096 + qb * 256)) * 2048 + h * 256 + vf * 128);
              r.P0 = NMETA + qb * 256; return r; };
          int L = vcu;
          if (L < 512) {
              int pass = 0; att::BlockRef cur = mk(L, 0);
              att::prime(cur, (char*)lds, S);
              for (;;) {
                  const bool more_pass = (pass == 0), more_item = (L + G < 512), last = !more_pass && !more_item;
                  int Ln = L, passn = pass + 1; if (!more_pass) { passn = 0; Ln = more_item ? L + G : L; }
                  const att::BlockRef nxt = last ? cur : mk(Ln, passn);
                  att::block(cur, nxt, TPAD, (char*)lds, S);
                  if (last) break;
                  cur = nxt; pass = passn; L = Ln;
              }
          } }
    }
    SEAM(2);
    if (IN(3)) {
        const KP KA = kargs(); unsigned char* const ws = KA->ws;
        bf16_t* Cat = QKV;
        float lam;
        { const float a1 = KA->in[4][lane] * KA->in[5][lane] + KA->in[4][lane + 64] * KA->in[5][lane + 64], a2 = KA->in[6][lane] * KA->in[7][lane] + KA->in[6][lane + 64] * KA->in[7][lane + 64];
          lam = expf(wave_sum(a1)) - expf(wave_sum(a2)) + 0.2f; }
        for (int row = gw; row < MX; row += 4 * NGW) {
            u32x4 av[4][4], bv[4][4];
#pragma unroll
            for (int q = 0; q < 4; ++q) { const int rq = (row + q * NGW < MX) ? row + q * NGW : row;
#pragma unroll
                for (int j = 0; j < 4; ++j) { const int col = (lane + 64 * j) * 8;
                    av[q][j] = *(const u32x4*)(Opart + (size_t)rq * 2048 + col); bv[q][j] = *(const u32x4*)(Opart + (size_t)MX * 2048 + (size_t)rq * 2048 + col); } }
#pragma unroll
            for (int q = 0; q < 4; ++q) { const int rq = row + q * NGW; if (rq < MX) {
#pragma unroll
            for (int j = 0; j < 4; ++j) { const int col = (lane + 64 * j) * 8;
                const u32x4 a = av[q][j], bq = bv[q][j];
                float d[8]; d[0] = bf_lo(a.x) - lam * bf_lo(bq.x); d[1] = bf_hi(a.x) - lam * bf_hi(bq.x); d[2] = bf_lo(a.y) - lam * bf_lo(bq.y); d[3] = bf_hi(a.y) - lam * bf_hi(bq.y);
                d[4] = bf_lo(a.z) - lam * bf_lo(bq.z); d[5] = bf_hi(a.z) - lam * bf_hi(bq.z); d[6] = bf_lo(a.w) - lam * bf_lo(bq.w); d[7] = bf_hi(a.w) - lam * bf_hi(bq.w);
                float ss = 0.f;
#pragma unroll
                for (int e = 0; e < 8; ++e) ss += d[e] * d[e];
                ss += __shfl_xor(ss, 1); ss += __shfl_xor(ss, 2); ss += __shfl_xor(ss, 4); ss += __shfl_xor(ss, 8); ss += __shfl_xor(ss, 16);
                const float rs = rsqrtf(ss * (1.f / 256.f) + EPS) * 0.8f;
                const f32x4 g0 = *(const f32x4*)(KA->in[8] + (col & 255)), g1 = *(const f32x4*)(KA->in[8] + (col & 255) + 4);
                u32x4 w; w.x = pk2(d[0] * rs * g0[0], d[1] * rs * g0[1]); w.y = pk2(d[2] * rs * g0[2], d[3] * rs * g0[3]); w.z = pk2(d[4] * rs * g1[0], d[5] * rs * g1[1]); w.w = pk2(d[6] * rs * g1[2], d[7] * rs * g1[3]);
                *(u32x4*)(Cat + (size_t)rq * DM + col) = w; } } }
        }
        for (int it = vcu; it < 2 * 64 * 4; it += G) {
            const int cq = it & 3, bg = it >> 2, b = bg >> 6, g = b ? 63 - (bg & 63) : (bg & 63), chq = tid & 127, rgp = tid >> 7, ch = cq * 512 + chq * 4;
            const int pos0 = NMETA + 64 * g + 16 * rgp, c64 = pos0 >> 6;
            u32x2 pwv[16], hwv[16], gwv[16];
#pragma unroll
            for (int tt = 0; tt < 16; ++tt) { const size_t go = ((size_t)(b * TPAD + pos0 + tt)) * 2048 + ch; pwv[tt] = *(const u32x2*)(Pc + go); hwv[tt] = *(const u32x2*)(Hloc + go); gwv[tt] = *(const u32x2*)(GTb + go); }
            f32x4 carry = (f32x4){0.f, 0.f, 0.f, 0.f};
            { int cc = 0;
              for (; cc + 8 <= c64; cc += 8) { f32x4 A8[8], B8[8];
#pragma unroll
                  for (int q = 0; q < 8; ++q) { A8[q] = *(const f32x4*)(Aagg + (b * 66 + cc + q) * 2048 + ch); B8[q] = *(const f32x4*)(Bagg + (b * 66 + cc + q) * 2048 + ch); }
#pragma unroll
                  for (int q = 0; q < 8; ++q) carry = A8[q] * carry + B8[q]; }
              f32x4 A8[8], B8[8];
#pragma unroll
              for (int q = 0; q < 8; ++q) { const int cq_ = (cc + q < c64) ? cc + q : 0; A8[q] = *(const f32x4*)(Aagg + (b * 66 + cq_) * 2048 + ch); B8[q] = *(const f32x4*)(Bagg + (b * 66 + cq_) * 2048 + ch); }
#pragma unroll
              for (int q = 0; q < 8; ++q) if (cc + q < c64) carry = A8[q] * carry + B8[q]; }
#pragma unroll
            for (int tt = 0; tt < 16; ++tt) { const int pos = pos0 + tt;
                const u32x2 pw2 = pwv[tt], hw2 = hwv[tt], gw2 = gwv[tt];
                const f32x4 P4 = (f32x4){bf_lo(pw2.x), bf_hi(pw2.x), bf_lo(pw2.y), bf_hi(pw2.y)}, h4 = (f32x4){bf_lo(hw2.x), bf_hi(hw2.x), bf_lo(hw2.y), bf_hi(hw2.y)};
                const f32x4 hh = h4 + P4 * carry; float gv[4] = {bf_lo(gw2.x), bf_hi(gw2.x), bf_lo(gw2.y), bf_hi(gw2.y)}; float ov[4];
#pragma unroll
                for (int e = 0; e < 4; ++e) { const float gg = gv[e], z2 = 1.5957691216057308f * (gg + 0.044715f * gg * gg * gg); ov[e] = hh[e] * gg * sigmoidf_(z2); }
                u32x2 w; w.x = pk2(ov[0], ov[1]); w.y = pk2(ov[2], ov[3]);
                *(u32x2*)(Cat + ((size_t)(b * 4096 + pos - NMETA)) * DM + 2048 + ch) = w; }
        }
    }
    SEAM(3);
    if (IN(4)) {
        const KP KA = kargs(); unsigned char* const ws = KA->ws;
        pg8::Gemm g{QKV, Wout_t, MX, DM, DM}; pg8::StaticOrder S; S.init(MX, DM, G, bx);
        pg8::EpiBfSsq E{Mixed, ssq1, DM};
        pg8::gemm_phase<pg8::EpiBfSsq, pg8::StaticOrder, true, true>((LAS unsigned char*)lds, g, S, E);
    }
    SEAM(4);
    if (IN(5)) {
        const KP KA = kargs(); unsigned char* const ws = KA->ws;
        for (int row = gw; row < MX; row += 2 * NGW) {
            const int rB = (row + NGW < MX) ? row + NGW : row; const bool hasB = row + NGW < MX;
            const float sA = ssq1[(size_t)row * 64 + lane], sB = ssq1[(size_t)rB * 64 + lane];
            u32x2 xa[16], xb[16], ma[16], mb[16];
            { const u32x2* m4 = (const u32x2*)(Mixed + (size_t)row * DM) + lane; const u32x2* x4 = (const u32x2*)(Ubuf + (size_t)row * DM) + lane;
#pragma unroll
              for (int j = 0; j < 16; ++j) { xa[j] = x4[64 * j]; ma[j] = m4[64 * j]; } }
            { const u32x2* m4 = (const u32x2*)(Mixed + (size_t)rB * DM) + lane; const u32x2* x4 = (const u32x2*)(Ubuf + (size_t)rB * DM) + lane;
#pragma unroll
              for (int j = 0; j < 16; ++j) { xb[j] = x4[64 * j]; mb[j] = m4[64 * j]; } }
            const f32x4* gp = (const f32x4*)KA->in[17] + lane;
#define P5_ROW(R, XV, MV, SS) do { const float rs1 = rsqrtf(wave_sum(SS) * (1.f / DM) + EPS); float s2 = 0.f; u32x2* h8 = (u32x2*)(H1b + (size_t)(R) * DM) + lane; \
                _Pragma("unroll") for (int j = 0; j < 16; ++j) { const u32x2 mw = MV[j], xw = XV[j]; const f32x4 mv = (f32x4){bf_lo(mw.x), bf_hi(mw.x), bf_lo(mw.y), bf_hi(mw.y)}, xv = (f32x4){bf_lo(xw.x), bf_hi(xw.x), bf_lo(xw.y), bf_hi(xw.y)}; \
                    const f32x4 h = xv + mv * rs1 * gp[64 * j]; \
                    { u32x2 hw; hw.x = pk2(h[0], h[1]); hw.y = pk2(h[2], h[3]); h8[64 * j] = hw; } s2 += (h[0] * h[0] + h[1] * h[1]) + (h[2] * h[2] + h[3] * h[3]); } \
                const float rs2 = rsqrtf(wave_sum(s2) * (1.f / DM) + EPS); if (lane == 0) RS2[R] = rs2; } while (0)
            P5_ROW(row, xa, ma, sA);
            if (hasB) P5_ROW(rB, xb, mb, sB);
#undef P5_ROW
        }
    }
    SEAM(5);
    if (IN(6)) {
        const KP KA = kargs(); unsigned char* const ws = KA->ws;
        pg8::Gemm g{H1b, Wgu_t, MX, NGU, DM}; pg8::StaticOrder S; S.init(MX, NGU, G, bx);
        pg8::EpiGU E{QKV, DFF, RS2};
        pg8::gemm_phase<pg8::EpiGU, pg8::StaticOrder, true, true>((LAS unsigned char*)lds, g, S, E);
        { const int rem = S.nwg % G, nshort = rem ? G - rem : G, sidx = rem ? bx - rem : bx;
          if (sidx >= 0) {
              __syncthreads();
              const KP KB = kargs(); bf16_t* const wdn = (bf16_t*)(KB->ws + WS_WDN);
              LAS float* scr = (LAS float*)((LAS unsigned char*)lds + wave * 16640);
              tr_run<DFF, DM>(KB->in[21], KB->in[21], 172 * 64, wdn, 0, 0, scr, WDN_EARLY + sidx * 8 + wave, 172 * 64, nshort * 8, lane);
          } }
    }
    SEAM(6);
    if (IN(7)) {
        const KP KA = kargs(); unsigned char* const ws = KA->ws;
        pg8::Gemm g{QKV, Wdn_t, MX, DM, DFF}; pg8::StaticOrder S; S.init(MX, DM, G, bx);
        pg8::EpiBfSsq E{Mixed, ssq2, DM};
        pg8::gemm_phase<pg8::EpiBfSsq, pg8::StaticOrder, true, true>((LAS unsigned char*)lds, g, S, E);
    }
    SEAM(7);
    if (IN(8)) {
        const KP KA = kargs(); unsigned char* const ws = KA->ws;
        const f32x4* gp = (const f32x4*)KA->in[22] + lane;
        for (int row = gw; row < MX; row += 2 * NGW) {
            const int rB = (row + NGW < MX) ? row + NGW : row; const bool hasB = row + NGW < MX;
            const float sA = ssq2[(size_t)row * 64 + lane], sB = ssq2[(size_t)rB * 64 + lane];
            u32x2 fa[16], ha[16], fb[16], hb[16];
            { const u32x2* f4 = (const u32x2*)(Mixed + (size_t)row * DM) + lane; const u32x2* h8 = (const u32x2*)(H1b + (size_t)row * DM) + lane;
#pragma unroll
              for (int j = 0; j < 16; ++j) { fa[j] = f4[64 * j]; ha[j] = h8[64 * j]; } }
            { const u32x2* f4 = (const u32x2*)(Mixed + (size_t)rB * DM) + lane; const u32x2* h8 = (const u32x2*)(H1b + (size_t)rB * DM) + lane;
#pragma unroll
              for (int j = 0; j < 16; ++j) { fb[j] = f4[64 * j]; hb[j] = h8[64 * j]; } }
#define P8_ROW(R, FV, HV, SS) do { const float rs = rsqrtf(wave_sum(SS) * (1.f / DM) + EPS); f32x4* o4 = (f32x4*)(KA->out + (size_t)(R) * DM) + lane; \
                _Pragma("unroll") for (int j = 0; j < 16; ++j) { const u32x2 fw = FV[j], hw = HV[j]; const f32x4 fv = (f32x4){bf_lo(fw.x), bf_hi(fw.x), bf_lo(fw.y), bf_hi(fw.y)}, hv = (f32x4){bf_lo(hw.x), bf_hi(hw.x), bf_lo(hw.y), bf_hi(hw.y)}; \
                    __builtin_nontemporal_store(hv + fv * rs * gp[64 * j], o4 + 64 * j); } } while (0)
            P8_ROW(row, fa, ha, sA);
            if (hasB) P8_ROW(rB, fb, hb, sB);
#undef P8_ROW
        }
    }
#undef IN
#undef SEAM
}

extern "C" void kernel_launch(void* const* d_in, const int* in_sizes, int n_in, void* d_out, int out_size, void* d_ws, size_t ws_size, hipStream_t stream) {
    static int grid = 0;
    if (grid == 0) {
        if (n_in != 23 || ws_size < WS_END) { fprintf(stderr, "kernel_launch: unexpected n_in %d or ws_size %zu (need %zu)\n", n_in, ws_size, (size_t)WS_END); }
        int dev = 0, cus = 0, per_cu = 0;
        (void)hipGetDevice(&dev); (void)hipDeviceGetAttribute(&cus, hipDeviceAttributeMultiprocessorCount, dev);
        if (hipFuncSetAttribute((const void*)fwd_mega, hipFuncAttributeMaxDynamicSharedMemorySize, LDS_BYTES) != hipSuccess) fprintf(stderr, "kernel_launch: hipFuncSetAttribute failed\n");
        if (hipOccupancyMaxActiveBlocksPerMultiprocessor(&per_cu, (const void*)fwd_mega, 512, LDS_BYTES) != hipSuccess || per_cu < 1) { fprintf(stderr, "kernel_launch: occupancy query says %d\n", per_cu); per_cu = 1; }
        (void)hipGetLastError();
        if (cus <= 0) cus = 256;
        grid = cus;
    }
    Params p{};
    for (int i = 0; i < 23; ++i) p.in[i] = (const float*)d_in[i];
    p.out = (float*)d_out; p.ws = (unsigned char*)d_ws;
    if (hipMemsetAsync((char*)d_ws + 4096, 0, XCD_BAR_WORDS * sizeof(unsigned), stream) != hipSuccess) fprintf(stderr, "kernel_launch: memset of the barrier words failed\n");
    const int nl = (PROBE_REP >= 0) ? 2 : MK_N_LAUNCHES;
    for (int li = 0; li < nl; ++li) {
        if (PROBE_REP >= 0) { p.ph_lo = li ? PROBE_REP : 0; p.ph_hi = li ? NPHASE : PROBE_REP + 1; }
        else if (MK_N_LAUNCHES == 1) { p.ph_lo = 0; p.ph_hi = NPHASE; } else { p.ph_lo = li; p.ph_hi = li + 1; }
        void* args[] = {&p};
        hipError_t e = hipLaunchCooperativeKernel((const void*)fwd_mega, dim3(grid), dim3(512), args, LDS_BYTES, stream);
        if (e != hipSuccess) { fprintf(stderr, "kernel_launch: cooperative launch %d failed: %s (grid %d)\n", li, hipGetErrorString(e), grid); break; }
    }
}
```
